# Optimizing an MI355X kernel written in HIP

```python
import jax
import jax.numpy as jnp
from jax import lax
import numpy as np

D_MODEL = 4096
BATCH = 1
SEQ = 16384
DEPTH = 1

N_META = 16
D_FF = ((8 * D_MODEL // 3 + 255) // 256) * 256
D_MIX = D_MODEL
HG_WIDTH = D_MIX // 2
HG_HEAD_DIM = 128
HG_HEADS = HG_WIDTH // HG_HEAD_DIM
MLA_WIDTH = D_MIX - HG_WIDTH
MLA_V_DIM = 128
MLA_HEADS = MLA_WIDTH // MLA_V_DIM
MLA_NOPE_DIM = 128
MLA_ROPE_DIM = 64
MLA_QK_DIM = MLA_NOPE_DIM + MLA_ROPE_DIM
Q_LORA_RANK = 1024
KV_LORA_RANK = 512
IN_SPLITS = (HG_WIDTH, HG_WIDTH, HG_WIDTH, HG_WIDTH, Q_LORA_RANK, KV_LORA_RANK, MLA_ROPE_DIM)
IN_COLS = sum(IN_SPLITS)
CHUNK = 64
Q_BLOCK = 128
ROPE_THETA = 10000.0
EPS = 1e-6

kernel_name = "hybrid_hgrn2_mla_macaron_meta"


def rms_norm(x, w):
    xf = x.astype(jnp.float32)
    y = xf * lax.rsqrt(jnp.mean(xf * xf, axis=-1, keepdims=True) + EPS)
    return (y * w.astype(jnp.float32)).astype(x.dtype)


def swiglu(x, w_gate, w_up, w_down):
    return (jax.nn.silu(x @ w_gate) * (x @ w_up)) @ w_down


def rope_tables(length):
    inv_freq = 1.0 / (ROPE_THETA ** (jnp.arange(0, MLA_ROPE_DIM, 2, dtype=jnp.float32) / MLA_ROPE_DIM))
    ang = jnp.arange(length, dtype=jnp.float32)[:, None] * inv_freq[None, :]
    return jnp.cos(ang), jnp.sin(ang)


def apply_rope(x, cos, sin):
    xf = x.astype(jnp.float32)
    x1, x2 = jnp.split(xf, 2, axis=-1)
    c = cos[None, :, None, :]
    s = sin[None, :, None, :]
    return jnp.concatenate([x1 * c - x2 * s, x2 * c + x1 * s], axis=-1).astype(x.dtype)


def gla_chunk(state, q, k, v, log_f):
    c = q.shape[1]
    b = jnp.cumsum(log_f, axis=1)
    o_inter = jnp.einsum('bthk,bhkv->bthv', q * jnp.exp(b), state)
    causal = jnp.tril(jnp.ones((c, c), dtype=bool))
    diff = b[:, :, None] - b[:, None, :]
    decay = jnp.exp(jnp.where(causal[None, :, :, None, None], diff, -jnp.inf))
    scores = jnp.einsum('bthk,bshk,btshk->bhts', q, k, decay)
    o_intra = jnp.einsum('bhts,bshv->bthv', scores, v)
    b_last = b[:, -1]
    k_dec = k * jnp.exp(b_last[:, None] - b)
    new_state = jnp.exp(b_last)[..., None] * state + jnp.einsum('bshk,bshv->bhkv', k_dec, v)
    return new_state, o_inter + o_intra


def hgrn2_recurrence(q, k, v, log_f):
    bsz, length, heads, dk = q.shape
    dv = v.shape[-1]
    state0 = jnp.zeros((bsz, heads, dk, dv), jnp.float32)
    state, o_meta = gla_chunk(state0, q[:, :N_META], k[:, :N_META], v[:, :N_META], log_f[:, :N_META])

    def to_chunks(t):
        return jnp.swapaxes(t[:, N_META:].reshape(bsz, -1, CHUNK, heads, t.shape[-1]), 0, 1)

    _, o_real = lax.scan(lambda s, inp: gla_chunk(s, *inp), state,
                         (to_chunks(q), to_chunks(k), to_chunks(v), to_chunks(log_f)))
    o_real = jnp.swapaxes(o_real, 0, 1).reshape(bsz, length - N_META, heads, dv)
    return jnp.concatenate([o_meta, o_real], axis=1)


def attend_block(q, k, v, q_pos, k_pos):
    s = jnp.einsum('bqhd,bkhd->bhqk', q, k).astype(jnp.float32) * (MLA_QK_DIM ** -0.5)
    s = jnp.where(k_pos[None, :] <= q_pos[:, None], s, -jnp.inf)
    p = jax.nn.softmax(s, axis=-1)
    return jnp.einsum('bhqk,bkhd->bqhd', p.astype(v.dtype), v)


def causal_attention(q, k, v):
    bsz, length, heads, dq = q.shape
    k_pos = jnp.arange(length)
    o_meta = attend_block(q[:, :N_META], k, v, jnp.arange(N_META), k_pos)
    n_blocks = (length - N_META) // Q_BLOCK
    q_blocks = jnp.swapaxes(q[:, N_META:].reshape(bsz, n_blocks, Q_BLOCK, heads, dq), 0, 1)
    q_pos = (N_META + jnp.arange(length - N_META)).reshape(n_blocks, Q_BLOCK)
    o_real = lax.map(lambda a: attend_block(a[0], k, v, a[1], k_pos), (q_blocks, q_pos))
    o_real = jnp.swapaxes(o_real, 0, 1).reshape(bsz, length - N_META, heads, v.shape[-1])
    return jnp.concatenate([o_meta, o_real], axis=1)


def hybrid_mixer(h, lb, w_in, hg_out_norm, mla_q_norm, mla_w_uq, mla_kv_norm, mla_w_ukv,
                 q_head_norm, k_head_norm, w_out, cos, sin):
    bsz, length, _ = h.shape
    u = h @ w_in
    split_points = [int(p) for p in np.cumsum(IN_SPLITS)[:-1]]
    hq, hf, hi, hg, cq, ckv, kr = jnp.split(u, split_points, axis=-1)

    def heads(t, n):
        return t.reshape(bsz, length, n, -1)

    lbh = lb.reshape(HG_HEADS, HG_HEAD_DIM)
    q_hg = jax.nn.silu(heads(hq, HG_HEADS).astype(jnp.float32))
    f = lbh + (1.0 - lbh) * jax.nn.sigmoid(heads(hf, HG_HEADS).astype(jnp.float32))
    k_hg = 1.0 - f
    v_hg = heads(hi, HG_HEADS).astype(jnp.float32)
    o_hg = hgrn2_recurrence(q_hg, k_hg, v_hg, jnp.log(f)).astype(h.dtype)
    o_hg = rms_norm(o_hg, hg_out_norm) * jax.nn.silu(heads(hg, HG_HEADS))

    q_m = heads(rms_norm(cq, mla_q_norm) @ mla_w_uq, MLA_HEADS)
    kv = heads(rms_norm(ckv, mla_kv_norm) @ mla_w_ukv, MLA_HEADS)
    k_nope, v_m = jnp.split(kv, [MLA_NOPE_DIM], axis=-1)
    k_rope = jnp.broadcast_to(kr[:, :, None, :], (bsz, length, MLA_HEADS, MLA_ROPE_DIM))
    k_m = jnp.concatenate([k_nope, k_rope], axis=-1)
    q_m = rms_norm(q_m, q_head_norm)
    k_m = rms_norm(k_m, k_head_norm)
    q_m = jnp.concatenate([q_m[..., :MLA_NOPE_DIM], apply_rope(q_m[..., MLA_NOPE_DIM:], cos, sin)], axis=-1)
    k_m = jnp.concatenate([k_m[..., :MLA_NOPE_DIM], apply_rope(k_m[..., MLA_NOPE_DIM:], cos, sin)], axis=-1)
    o_m = causal_attention(q_m, k_m, v_m)

    mixed = jnp.concatenate([o_hg.reshape(bsz, length, HG_WIDTH),
                             o_m.reshape(bsz, length, MLA_WIDTH)], axis=-1)
    return mixed @ w_out


def _normal(k, shape, scale):
    return jax.random.normal(k, shape, jnp.float32) * scale


def setup_inputs(seed: int = 0) -> dict:
    key = jax.random.key(seed)
    ks = jax.random.split(key, 24)
    gain = lambda k, shape: 1.0 + _normal(k, shape, 0.02)
    return {
        "x": _normal(ks[0], (BATCH, SEQ, D_MODEL), 1.0),
        "meta_tokens": _normal(ks[1], (N_META, D_MODEL), 1.0),
        "lb_param": _normal(ks[2], (DEPTH + 1, HG_WIDTH), 0.5),
        "ffn1_norm": gain(ks[3], (DEPTH, D_MODEL)),
        "ffn1_w_gate": _normal(ks[4], (DEPTH, D_MODEL, D_FF), D_MODEL ** -0.5),
        "ffn1_w_up": _normal(ks[5], (DEPTH, D_MODEL, D_FF), D_MODEL ** -0.5),
        "ffn1_w_down": _normal(ks[6], (DEPTH, D_FF, D_MODEL), D_FF ** -0.5),
        "mix_norm": gain(ks[7], (DEPTH, D_MODEL)),
        "w_in": _normal(ks[8], (DEPTH, D_MODEL, IN_COLS), D_MODEL ** -0.5),
        "hg_out_norm": gain(ks[9], (DEPTH, HG_HEADS, HG_HEAD_DIM)),
        "mla_q_norm": gain(ks[10], (DEPTH, Q_LORA_RANK)),
        "mla_w_uq": _normal(ks[11], (DEPTH, Q_LORA_RANK, MLA_HEADS * MLA_QK_DIM), Q_LORA_RANK ** -0.5),
        "mla_kv_norm": gain(ks[12], (DEPTH, KV_LORA_RANK)),
        "mla_w_ukv": _normal(ks[13], (DEPTH, KV_LORA_RANK, MLA_HEADS * (MLA_NOPE_DIM + MLA_V_DIM)), KV_LORA_RANK ** -0.5),
        "q_head_norm": gain(ks[14], (DEPTH, MLA_QK_DIM)),
        "k_head_norm": gain(ks[15], (DEPTH, MLA_QK_DIM)),
        "w_out": _normal(ks[16], (DEPTH, D_MIX, D_MODEL), D_MIX ** -0.5),
        "ffn2_norm": gain(ks[17], (DEPTH, D_MODEL)),
        "ffn2_w_gate": _normal(ks[18], (DEPTH, D_MODEL, D_FF), D_MODEL ** -0.5),
        "ffn2_w_up": _normal(ks[19], (DEPTH, D_MODEL, D_FF), D_MODEL ** -0.5),
        "ffn2_w_down": _normal(ks[20], (DEPTH, D_FF, D_MODEL), D_FF ** -0.5),
        "out_norm": gain(ks[21], (DEPTH, D_MODEL)),
    }


def reference(x, meta_tokens, lb_param, ffn1_norm, ffn1_w_gate, ffn1_w_up, ffn1_w_down,
              mix_norm, w_in, hg_out_norm, mla_q_norm, mla_w_uq, mla_kv_norm, mla_w_ukv,
              q_head_norm, k_head_norm, w_out, ffn2_norm, ffn2_w_gate, ffn2_w_up, ffn2_w_down,
              out_norm):
    bsz = x.shape[0]
    meta = jnp.broadcast_to(meta_tokens.astype(x.dtype)[None], (bsz, N_META, D_MODEL))
    h = jnp.concatenate([meta, x], axis=1)
    cos, sin = rope_tables(h.shape[1])
    lb_all = jnp.cumsum(jax.nn.softmax(lb_param.astype(jnp.float32), axis=0), axis=0)
    for l in range(DEPTH):
        h = h + 0.5 * swiglu(rms_norm(h, ffn1_norm[l]), ffn1_w_gate[l], ffn1_w_up[l], ffn1_w_down[l])
        h = h + hybrid_mixer(rms_norm(h, mix_norm[l]), lb_all[l], w_in[l], hg_out_norm[l],
                             mla_q_norm[l], mla_w_uq[l], mla_kv_norm[l], mla_w_ukv[l],
                             q_head_norm[l], k_head_norm[l], w_out[l], cos, sin)
        h = h + 0.5 * swiglu(rms_norm(h, ffn2_norm[l]), ffn2_w_gate[l], ffn2_w_up[l], ffn2_w_down[l])
        h = rms_norm(h, out_norm[l])
    return h[:, N_META:]
```

```cpp
#include <hip/hip_runtime.h>
#include <cstdio>
#include <cstdint>
#ifndef MK_SINGLE
#define MK_SINGLE 1
#endif
namespace pg8 {
#define PG8_LAS __attribute__((address_space(3)))
typedef unsigned short bf16_t;
typedef short bf16x8 __attribute__((ext_vector_type(8)));
typedef float f32x4 __attribute__((ext_vector_type(4)));
typedef unsigned u32x4 __attribute__((ext_vector_type(4)));
constexpr int BM = 256, BK = 64, HALF = 128, HTB = HALF * BK * 2  , STAGE_BYTES = 8 * HTB, NXCD = 8, WGM = 8;

__host__ __device__ __forceinline__ int lds_byte(int r, int c) { const int st = (r >> 4) * 2 + (c >> 5), rr = r & 15, cc = c & 31, ob = rr * 64 + cc * 2; return st * 1024 + (ob ^ (((ob >> 9) & 1) << 5)); }
__host__ __device__ __forceinline__ void stage_rc(int b, int& R, int& C) { const int st = b / 1024, sb = b % 1024, swz = sb ^ (((sb >> 9) & 1) << 5); R = (st >> 1) * 16 + swz / 64; C = (st & 1) * 32 + (swz % 64) / 2; }
__host__ __device__ __forceinline__ int perm32(int rho) { const int n = rho >> 4, i = rho & 15; return 8 * (i >> 2) + 4 * n + (i & 3); }

struct Unit { int pm, pn; };
struct Gemm { const bf16_t* A; const bf16_t* Bt; int M, N, K; };

struct StaticOrder {
    int nM, nN, nwg, G, c, wgm;
    __host__ __device__ void init(int M, int N, int G_, int c_, int wgm_ = WGM) { nM = M / BM; nN = N / BM; nwg = nM * nN; G = G_; c = c_; wgm = wgm_; }
    __host__ __device__ bool next(int i, Unit& u) const {
        const long L = (long)i * G + c; if (L >= nwg) return false;
        int wgid = (int)L; { const int q = nwg / NXCD, r = nwg % NXCD, xcd = wgid % NXCD, off = wgid / NXCD; wgid = (xcd < r ? xcd * (q + 1) : r * (q + 1) + (xcd - r) * q) + off; }
        const int nig = wgm * nN, gid = wgid / nig, fm = gid * wgm, gsz = (nM - fm) < wgm ? (nM - fm) : wgm;
        u.pm = fm + ((wgid % nig) % gsz); u.pn = (wgid % nig) / gsz; return true;
    }
    __device__ __forceinline__ void a_ready(const Unit&) const {}
    __device__ __forceinline__ void done(const Unit&) const {}
};

__device__ __forceinline__ unsigned cvt_pk_bf16(float lo, float hi) { unsigned r; asm volatile("v_cvt_pk_bf16_f32 %0, %1, %2" : "=v"(r) : "v"(lo), "v"(hi)); return r; }
typedef float f32x2 __attribute__((ext_vector_type(2)));

__device__ __forceinline__ unsigned pk_bf16(float lo, float hi) {
    typedef __bf16 bf2_t __attribute__((ext_vector_type(2))); const f32x2 v = {lo, hi}; return __builtin_bit_cast(unsigned, __builtin_convertvector(v, bf2_t)); }
__device__ __forceinline__ float fsigmoid(float x) { return __builtin_amdgcn_rcpf(1.0f + __builtin_amdgcn_exp2f(-1.4426950408889634f * x)); }
__device__ __forceinline__ float fsilu(float x) { return x * fsigmoid(x); }

template <bool RS> struct EpiSwiglu {
    static constexpr bool PERM = true, AFTER_DRAIN = false;
    bf16_t* O; int ldc; const float* stat;
    __device__ __forceinline__ void operator()(const f32x4 (&acc)[2][2][4][2], const Unit& u, int wr, int wc, int fr, int fq) const {
        const int row0 = u.pm * BM + wr * 64 + fr, col0 = u.pn * HALF + wc * 32 + 8 * fq;
#pragma unroll
        for (int ai = 0; ai < 2; ++ai)
#pragma unroll
            for (int m = 0; m < 4; ++m) { const int row = row0 + ai * HALF + m * 16; bf16_t* rowp = O + (size_t)row * ldc + col0;
                f32x4 g0 = acc[ai][0][m][0], g1 = acc[ai][0][m][1], u0 = acc[ai][1][m][0], u1 = acc[ai][1][m][1];
                if (RS) { const float rs = 1.0f / sqrtf(stat[row] * (1.0f / 4096.0f) + 1e-6f); g0 *= rs; g1 *= rs; u0 *= rs; u1 *= rs; }
                u32x4 w; w.x = pk_bf16(fsilu(g0[0]) * u0[0], fsilu(g0[1]) * u0[1]); w.y = pk_bf16(fsilu(g0[2]) * u0[2], fsilu(g0[3]) * u0[3]);
                w.z = pk_bf16(fsilu(g1[0]) * u1[0], fsilu(g1[1]) * u1[1]); w.w = pk_bf16(fsilu(g1[2]) * u1[2], fsilu(g1[3]) * u1[3]);
                *(u32x4*)rowp = w; }
    }
};
template <bool COPY, size_t XBOFF, size_t STOFF, size_t GOFF> struct EpiResid {
    static constexpr bool PERM = false, AFTER_DRAIN = false;
    const float* base; float* out; int ldc; float scale; unsigned char* ws;
    __device__ __forceinline__ void operator()(const f32x4 (&acc)[2][2][4][2], const Unit& u, int wr, int wc, int fr, int fq) const {
        const int row0 = u.pm * BM + wr * 64 + fr, col0 = u.pn * BM + wc * 32 + 4 * fq;
        bf16_t* XB = (bf16_t*)(ws + XBOFF); float* stat = (float*)(ws + STOFF); const float* gain = (const float*)(ws + GOFF);
        typedef unsigned u32x2_ __attribute__((ext_vector_type(2)));
        f32x4 pre[2][2][2][2]; float ssq[8];
#define ER_LOAD(q, buf) do { _Pragma("unroll") for (int mm = 0; mm < 2; ++mm) { const size_t off_ = (size_t)(row0 + ((q) >> 1) * HALF + (2 * ((q) & 1) + mm) * 16) * ldc + col0; \
            _Pragma("unroll") for (int bj = 0; bj < 2; ++bj) _Pragma("unroll") for (int n = 0; n < 2; ++n) pre[buf][mm][bj][n] = *(const f32x4*)(base + off_ + bj * HALF + n * 16); } } while (0)
        ER_LOAD(0, 0);
#pragma unroll
        for (int q = 0; q < 4; ++q) {
            if (q == 0) ER_LOAD(1, 1); else if (q == 1) ER_LOAD(2, 0); else if (q == 2) ER_LOAD(3, 1);
#pragma unroll
            for (int mm = 0; mm < 2; ++mm) { const int ai = q >> 1, m = 2 * (q & 1) + mm; const size_t off = (size_t)(row0 + ai * HALF + m * 16) * ldc + col0; float ss = 0.f;
#pragma unroll
                for (int bj = 0; bj < 2; ++bj)
#pragma unroll
                    for (int n = 0; n < 2; ++n) {
                        const f32x4 o = pre[q & 1][mm][bj][n] + acc[ai][bj][m][n] * scale;
                        *(f32x4*)(out + off + bj * HALF + n * 16) = o;
                        if (COPY) { const f32x4 gn = *(const f32x4*)(gain + col0 + bj * HALF + n * 16); u32x2_ w; w.x = pk_bf16(o[0] * gn[0], o[1] * gn[1]); w.y = pk_bf16(o[2] * gn[2], o[3] * gn[3]); *(u32x2_*)(XB + off + bj * HALF + n * 16) = w; ss += (o[0] * o[0] + o[1] * o[1]) + (o[2] * o[2] + o[3] * o[3]); } }
                if (COPY) { ss += __shfl_xor(ss, 16); ss += __shfl_xor(ss, 32); ssq[2 * q + mm] = ss; } }
        }
#undef ER_LOAD
        if (COPY) { if (fq == 0) {
#pragma unroll
            for (int i = 0; i < 8; ++i) atomicAdd(stat + row0 + (i >> 2) * HALF + (i & 3) * 16, ssq[i]); } }
    }
};
struct EpiPlain {
    static constexpr bool PERM = true, AFTER_DRAIN = false;
    bf16_t* O; int ldc;
    __device__ __forceinline__ void operator()(const f32x4 (&acc)[2][2][4][2], const Unit& u, int wr, int wc, int fr, int fq) const {
        const int row0 = u.pm * BM + wr * 64 + fr, col0 = u.pn * BM + wc * 32 + 8 * fq;
#pragma unroll
        for (int ai = 0; ai < 2; ++ai)
#pragma unroll
            for (int m = 0; m < 4; ++m) { bf16_t* rowp = O + (size_t)(row0 + ai * HALF + m * 16) * ldc + col0;
#pragma unroll
                for (int bj = 0; bj < 2; ++bj) { const f32x4 v0 = acc[ai][bj][m][0], v1 = acc[ai][bj][m][1];
                    u32x4 w; w.x = pk_bf16(v0[0], v0[1]); w.y = pk_bf16(v0[2], v0[3]); w.z = pk_bf16(v1[0], v1[1]); w.w = pk_bf16(v1[2], v1[3]);
                    *(u32x4*)(rowp + bj * HALF) = w; } }
    }
};
struct EpiWin {
    static constexpr bool PERM = true, AFTER_DRAIN = false;
    bf16_t *HQ, *HV, *G, *CQ, *CKV, *KR; float* LOGF; const float* lb; const float* stat;
    __device__ __forceinline__ void operator()(const f32x4 (&acc)[2][2][4][2], const Unit& u, int wr, int wc, int fr, int fq) const {
        const int pn = u.pn;
        int mode, ld, cbase, espace; bf16_t* dst = nullptr;
        if (pn < 8)       { mode = 1; dst = HQ;  ld = 2048; cbase = pn * 256;        espace = 1; }
        else if (pn < 16) { mode = 2; dst = nullptr; ld = 2048; cbase = (pn - 8) * 256;  espace = 1; }
        else if (pn < 24) { mode = 0; dst = HV;  ld = 2048; cbase = (pn - 16) * 256; espace = 1; }
        else if (pn < 32) { mode = 1; dst = G;   ld = 2048; cbase = (pn - 24) * 256; espace = 0; }
        else if (pn < 36) { mode = 0; dst = CQ;  ld = 1024; cbase = (pn - 32) * 256; espace = 0; }
        else if (pn < 38) { mode = 0; dst = CKV; ld = 512;  cbase = (pn - 36) * 256; espace = 0; }
        else              { mode = 0; dst = KR;  ld = 64;   cbase = 0;               espace = 0; }
#pragma unroll
        for (int ai = 0; ai < 2; ++ai)
#pragma unroll
            for (int m = 0; m < 4; ++m) {
                const int r = u.pm * BM + ai * HALF + wr * 64 + m * 16 + fr;
                if (u.pm * BM + ai * HALF + wr * 64 + m * 16 >= 16400) continue;
                const int drow = espace ? (r < 16384 ? r + 64 : r - 16384 + 48) : r;
                const float rs = 1.0f / sqrtf(stat[r] * (1.0f / 4096.0f) + 1e-6f);
#pragma unroll
                for (int bj = 0; bj < 2; ++bj) {
                    const int c = bj * HALF + wc * 32 + 8 * fq;
                    if (pn == 38 && c >= 64) continue;
                    const f32x4 v0 = acc[ai][bj][m][0] * rs, v1 = acc[ai][bj][m][1] * rs;
                    if (mode == 2) {
                        const f32x4 l0 = *(const f32x4*)(lb + cbase + c), l1 = *(const f32x4*)(lb + cbase + c + 4); f32x4 o0, o1;
#pragma unroll
                        for (int j = 0; j < 4; ++j) { o0[j] = __logf(l0[j] + (1.0f - l0[j]) * fsigmoid(v0[j])); o1[j] = __logf(l1[j] + (1.0f - l1[j]) * fsigmoid(v1[j])); }
                        float* p = LOGF + (size_t)drow * ld + cbase + c; *(f32x4*)p = o0; *(f32x4*)(p + 4) = o1;
                    } else {
                        u32x4 w;
                        if (mode == 1) { w.x = pk_bf16(fsilu(v0[0]), fsilu(v0[1])); w.y = pk_bf16(fsilu(v0[2]), fsilu(v0[3])); w.z = pk_bf16(fsilu(v1[0]), fsilu(v1[1])); w.w = pk_bf16(fsilu(v1[2]), fsilu(v1[3])); }
                        else { w.x = pk_bf16(v0[0], v0[1]); w.y = pk_bf16(v0[2], v0[3]); w.z = pk_bf16(v1[0], v1[1]); w.w = pk_bf16(v1[2], v1[3]); }
                        *(u32x4*)(dst + (size_t)drow * ld + cbase + c) = w;
                    }
                }
            }
    }
};
template <class Epi, class Sched, bool ALIGN_EPI = false, bool SP2 = false>
__device__ __forceinline__ void gemm_phase(PG8_LAS unsigned char* lds, const Gemm g, const Sched& S, const Epi& E) {
    const int tid = threadIdx.x, wid = __builtin_amdgcn_readfirstlane(tid >> 6), lane = tid & 63, wr = wid >> 2, wc = wid & 3, fr = lane & 15, fq = lane >> 4;
    const int K = g.K, nt = K / BK;
    unsigned voffA[2], voffB[2];
#pragma unroll
    for (int i = 0; i < 2; ++i) { int R, C; stage_rc(tid * 16 + i * 8192, R, C); const int Rb = Epi::PERM ? ((R & ~31) + perm32(R & 31)) : R;
        voffA[i] = (unsigned)(R * K + C) * 2u; voffB[i] = (unsigned)(Rb * K + C) * 2u; }
    const size_t kstep = (size_t)(BK * 2);
    const size_t hstep = (size_t)HALF * K * 2;
    const size_t tstep = 2 * hstep;
    const unsigned ldsw = (unsigned)wid * 1024u;
    const int aoff = lds_byte(wr * 64 + fr, fq * 8), boff = lds_byte(wc * 32 + fr, fq * 8);
#define PG8_SA(b, h) (((b) * 2 + (h)) * HTB)
#define PG8_SB(b, h) ((4 + (b) * 2 + (h)) * HTB)
#define PG8_STAGE(bufoff, gbase, voff) do { _Pragma("unroll") for (int _i = 0; _i < 2; ++_i) \
        __builtin_amdgcn_global_load_lds((const unsigned*)((const char*)(gbase) + (voff)[_i]), (PG8_LAS unsigned*)(lds + (bufoff) + ldsw + _i * 8192), 16, 0, 0); } while (0)
#define PG8_LDA(dst, b, h) do { _Pragma("unroll") for (int m = 0; m < 4; ++m) _Pragma("unroll") for (int k = 0; k < 2; ++k) dst[m][k] = *(const PG8_LAS bf16x8*)(lds + PG8_SA(b, h) + aoff + m * 2048 + k * 1024); } while (0)
#define PG8_LDB(dst, b, h) do { _Pragma("unroll") for (int n = 0; n < 2; ++n) _Pragma("unroll") for (int k = 0; k < 2; ++k) dst[n][k] = *(const PG8_LAS bf16x8*)(lds + PG8_SB(b, h) + boff + n * 2048 + k * 1024); } while (0)
#define PG8_MMA(ai, bj, At, Bt) do { __builtin_amdgcn_s_setprio(1); _Pragma("unroll") for (int m = 0; m < 4; ++m) _Pragma("unroll") for (int n = 0; n < 2; ++n) _Pragma("unroll") for (int k = 0; k < 2; ++k) \
        acc[ai][bj][m][n] = __builtin_amdgcn_mfma_f32_16x16x32_bf16(Bt[n][k], At[m][k], acc[ai][bj][m][n], 0, 0, 0); __builtin_amdgcn_s_setprio(0); } while (0)
#define PG8_WAIT_V(n) asm volatile("s_waitcnt vmcnt(" #n ")" ::: "memory")
#define PG8_WAIT_L(n) asm volatile("s_waitcnt lgkmcnt(" #n ")" ::: "memory")
#define PG8_BAR __builtin_amdgcn_s_barrier()
#define PG8_SCHED __builtin_amdgcn_sched_barrier(0)
    Unit cur, nxt; int ui = 0;
    if (!S.next(0, cur)) return;
    f32x4 acc[2][2][4][2];
#pragma unroll
    for (int a = 0; a < 2; ++a)
#pragma unroll
        for (int b = 0; b < 2; ++b)
#pragma unroll
            for (int m = 0; m < 4; ++m)
#pragma unroll
                for (int n = 0; n < 2; ++n) acc[a][b][m][n] = (f32x4){0.f, 0.f, 0.f, 0.f};
    bf16x8 At[4][2], B0[2][2], B1[2][2];
    const char* cA = (const char*)g.A + (size_t)cur.pm * tstep; const char* cB = (const char*)g.Bt + (size_t)cur.pn * tstep;
    S.a_ready(cur);
    if constexpr (SP2) {
        PG8_STAGE(PG8_SB(0, 0), cB, voffB); PG8_STAGE(PG8_SB(0, 1), cB + hstep, voffB); PG8_STAGE(PG8_SA(0, 0), cA, voffA); PG8_STAGE(PG8_SA(0, 1), cA + hstep, voffA);
        if (wr == 1) PG8_BAR;
        PG8_WAIT_V(2); PG8_BAR;
        PG8_STAGE(PG8_SB(1, 0), cB + kstep, voffB); PG8_STAGE(PG8_SA(1, 0), cA + kstep, voffA); PG8_STAGE(PG8_SB(1, 1), cB + hstep + kstep, voffB);
        PG8_WAIT_V(6); PG8_BAR;
    } else {
        PG8_STAGE(PG8_SB(0, 0), cB, voffB); PG8_STAGE(PG8_SA(0, 0), cA, voffA); PG8_STAGE(PG8_SB(0, 1), cB + hstep, voffB); PG8_STAGE(PG8_SA(0, 1), cA + hstep, voffA);
        if (wr == 1) PG8_BAR;
        PG8_WAIT_V(4); PG8_BAR;
        PG8_STAGE(PG8_SB(1, 0), cB + kstep, voffB); PG8_STAGE(PG8_SA(1, 0), cA + kstep, voffA); PG8_STAGE(PG8_SB(1, 1), cB + hstep + kstep, voffB);
        PG8_WAIT_V(6); PG8_BAR;
    }
    for (;;) {
        const bool has_next = S.next(ui + 1, nxt);
        const char* nA = has_next ? (const char*)g.A + (size_t)nxt.pm * tstep : cA; const char* nB = has_next ? (const char*)g.Bt + (size_t)nxt.pn * tstep : cB;
        for (int t = 0; t < nt; t += 2) {
            const bool last = (t == nt - 2);
            const char* a1 = cA + (size_t)(t + 1) * kstep;
            const char* a2 = last ? nA : cA + (size_t)(t + 2) * kstep; const char* b2 = last ? nB : cB + (size_t)(t + 2) * kstep;
            const char* a3 = a2 + kstep; const char* b3 = b2 + kstep;
            if (last && has_next) S.a_ready(nxt);
            if constexpr (SP2) {
            PG8_LDB(B0, 0, 0); PG8_LDB(B1, 0, 1); PG8_SCHED; PG8_LDA(At, 0, 0); PG8_STAGE(PG8_SA(1, 1), a1 + hstep, voffA);
            PG8_WAIT_V(8); PG8_WAIT_L(0); PG8_BAR; PG8_MMA(0, 0, At, B0); PG8_MMA(0, 1, At, B1); PG8_BAR; PG8_SCHED;
            PG8_LDA(At, 0, 1); PG8_STAGE(PG8_SB(0, 0), b2, voffB); PG8_STAGE(PG8_SB(0, 1), b2 + hstep, voffB); PG8_STAGE(PG8_SA(0, 0), a2, voffA);
            PG8_WAIT_V(8); PG8_WAIT_L(0); PG8_BAR; PG8_MMA(1, 0, At, B0); PG8_MMA(1, 1, At, B1); PG8_BAR; PG8_SCHED;
            PG8_LDB(B0, 1, 0); PG8_LDB(B1, 1, 1); PG8_SCHED; PG8_LDA(At, 1, 0); PG8_STAGE(PG8_SA(0, 1), a2 + hstep, voffA);
            PG8_WAIT_V(8); PG8_WAIT_L(0); PG8_BAR; PG8_MMA(0, 0, At, B0); PG8_MMA(0, 1, At, B1); PG8_BAR; PG8_SCHED;
            PG8_LDA(At, 1, 1); PG8_STAGE(PG8_SB(1, 0), b3, voffB); PG8_STAGE(PG8_SB(1, 1), b3 + hstep, voffB); PG8_STAGE(PG8_SA(1, 0), a3, voffA);
            PG8_WAIT_V(8); PG8_WAIT_L(0); PG8_BAR; PG8_MMA(1, 0, At, B0); PG8_MMA(1, 1, At, B1); PG8_BAR; PG8_SCHED;
            } else {
            PG8_LDB(B0, 0, 0); PG8_SCHED; PG8_LDA(At, 0, 0); PG8_STAGE(PG8_SA(1, 1), a1 + hstep, voffA);
            PG8_WAIT_L(8); PG8_BAR; PG8_WAIT_L(0); PG8_MMA(0, 0, At, B0); PG8_BAR; PG8_SCHED;
            PG8_LDB(B1, 0, 1); PG8_STAGE(PG8_SB(0, 0), b2, voffB);
            PG8_BAR; PG8_WAIT_L(0); PG8_MMA(0, 1, At, B1); PG8_BAR;
            PG8_LDA(At, 0, 1); PG8_STAGE(PG8_SA(0, 0), a2, voffA);
            PG8_BAR; PG8_WAIT_L(0); PG8_MMA(1, 0, At, B0); PG8_BAR; PG8_SCHED;
            PG8_STAGE(PG8_SB(0, 1), b2 + hstep, voffB);
            PG8_WAIT_V(6); PG8_BAR; PG8_MMA(1, 1, At, B1); PG8_BAR;
            PG8_LDB(B0, 1, 0); PG8_SCHED; PG8_LDA(At, 1, 0); PG8_STAGE(PG8_SA(0, 1), a2 + hstep, voffA);
            PG8_WAIT_L(8); PG8_BAR; PG8_WAIT_L(0); PG8_MMA(0, 0, At, B0); PG8_BAR; PG8_SCHED;
            PG8_LDB(B1, 1, 1); PG8_STAGE(PG8_SB(1, 0), b3, voffB);
            PG8_BAR; PG8_WAIT_L(0); PG8_MMA(0, 1, At, B1); PG8_BAR;
            PG8_LDA(At, 1, 1); PG8_STAGE(PG8_SA(1, 0), a3, voffA);
            PG8_BAR; PG8_WAIT_L(0); PG8_MMA(1, 0, At, B0); PG8_BAR; PG8_SCHED;
            PG8_STAGE(PG8_SB(1, 1), b3 + hstep, voffB);
            PG8_WAIT_V(6); PG8_BAR; PG8_MMA(1, 1, At, B1); PG8_BAR;
            }
        }
        if constexpr (ALIGN_EPI) { if (wr == 0) PG8_BAR; }
        if constexpr (!Epi::AFTER_DRAIN) { E(acc, cur, wr, wc, fr, fq); S.done(cur); }
        if (!has_next) break;
#pragma unroll
        for (int a = 0; a < 2; ++a)
#pragma unroll
            for (int b = 0; b < 2; ++b)
#pragma unroll
                for (int m = 0; m < 4; ++m)
#pragma unroll
                    for (int n = 0; n < 2; ++n) acc[a][b][m][n] = (f32x4){0.f, 0.f, 0.f, 0.f};
        cur = nxt; cA = nA; cB = nB; ++ui;
        if constexpr (ALIGN_EPI) { if (wr == 1) PG8_BAR; }
    }
    PG8_WAIT_V(0);
    if constexpr (!ALIGN_EPI) { if (wr == 0) PG8_BAR; }
    PG8_BAR;
    if constexpr (Epi::AFTER_DRAIN) { E.fused(acc, cur, wr, wc, fr, fq, lds, wid, lane); S.done(cur); }
#undef PG8_SA
#undef PG8_SB
#undef PG8_STAGE
#undef PG8_LDA
#undef PG8_LDB
#undef PG8_MMA
#undef PG8_WAIT_V
#undef PG8_WAIT_L
#undef PG8_BAR
#undef PG8_SCHED
}
}

constexpr int D = 4096, DFF = 11008, SEQ = 16384, NMETA = 16, LTOT = 16400, MP = 16640;
constexpr int NH = 16, HD = 128, HGW = 2048;
constexpr int QL = 1024, KVL = 512, RD = 64, QKD = 192;
constexpr int INC = 9792, INCP = 9984;
constexpr int ER = 16448;
constexpr int NKT = 257;
constexpr int NCH = 256;
constexpr float EPS = 1e-6f;
constexpr float QSCALE = 0.07216878364870322f * 1.4426950408889634f;
constexpr int NWAVES = 8;

constexpr size_t MiB = 1u << 20;
constexpr size_t al(size_t x) { return (x + MiB - 1) / MiB * MiB; }
constexpr size_t WS_CTL = 0, CTL_ZERO_BYTES = 1 * MiB;
constexpr size_t WS_LB = 1 * MiB;
constexpr size_t WS_G1 = WS_LB + 16384, WS_G2 = WS_LB + 32768;
constexpr size_t WS_COS = WS_LB + 65536, WS_SIN = WS_COS + al((size_t)LTOT * 32 * 4);
constexpr size_t WS_W1GU = WS_SIN + al((size_t)LTOT * 32 * 4);
constexpr size_t WS_W1D = WS_W1GU + al((size_t)2 * DFF * D * 2);
constexpr size_t WS_W2GU = WS_W1D + al((size_t)D * DFF * 2);
constexpr size_t WS_W2D = WS_W2GU + al((size_t)2 * DFF * D * 2);
constexpr size_t WS_WIN = WS_W2D + al((size_t)D * DFF * 2);
constexpr size_t WS_WUQ = WS_WIN + al((size_t)INCP * D * 2);
constexpr size_t WS_WUKV = WS_WUQ + al((size_t)3072 * QL * 2);
constexpr size_t WS_WOUT = WS_WUKV + al((size_t)4096 * KVL * 2);
constexpr size_t WS_HM = WS_WOUT + al((size_t)D * D * 2);
constexpr size_t WS_ARENA = WS_HM + al((size_t)256 * D * 4);
constexpr size_t AR_ACT = WS_ARENA;
constexpr size_t AR_XN = AR_ACT + al((size_t)MP * DFF * 2);
constexpr size_t AR_EXTRA = AR_XN + al((size_t)MP * D * 2);
constexpr size_t AR_HQ = AR_ACT;
constexpr size_t AR_LOGF = AR_HQ + al((size_t)ER * HGW * 2);
constexpr size_t AR_HV = AR_LOGF + al((size_t)ER * HGW * 4);
constexpr size_t AR_G = AR_HV + al((size_t)ER * HGW * 2);
constexpr size_t AR_G_END = AR_G + al((size_t)MP * HGW * 2);
static_assert(AR_G_END <= AR_XN, "P4 outputs must not touch XN");
constexpr size_t AR_MIXED = AR_XN;
constexpr size_t AR_CQ = AR_EXTRA;
constexpr size_t AR_CKV = AR_CQ + al((size_t)MP * QL * 2);
constexpr size_t AR_KR = AR_CKV + al((size_t)MP * KVL * 2);
constexpr size_t AR_CQN = AR_KR + al((size_t)MP * RD * 2);
constexpr size_t AR_CKVN = AR_CQN + al((size_t)MP * QL * 2);
constexpr size_t AR_SU = AR_CKVN + al((size_t)MP * KVL * 2);
constexpr size_t AR_AC = AR_SU + al((size_t)NCH * NH * HD * HD * 2);
constexpr size_t AR_AC_END = AR_AC + al((size_t)NCH * NH * HD * 4);
constexpr size_t AR_QRAW = AR_ACT;
constexpr size_t AR_KVRAW = AR_QRAW + al((size_t)SEQ * 3072 * 2);
constexpr size_t AR_QH = AR_KVRAW + al((size_t)MP * 4096 * 2);
constexpr size_t AR_QH_END = AR_QH + al((size_t)NH * SEQ * QKD * 2);
static_assert(AR_QH_END <= AR_XN, "QH inside the ACT area");
constexpr size_t AR_XN2 = AR_EXTRA;
constexpr size_t AR_KH = AR_SU;
constexpr size_t AR_VT = AR_KH + al((size_t)NH * NKT * 24576);
constexpr size_t AR_VT_END = AR_VT + al((size_t)NH * NKT * 16384);
constexpr size_t WS_END = (AR_VT_END > AR_AC_END ? AR_VT_END : AR_AC_END);
static_assert(AR_XN2 + (size_t)SEQ * D * 2 <= WS_END, "XN2 inside the extra area");

constexpr int CW_BAR = 4096;
constexpr size_t CTL_STAT1 = 65536, CTL_STAT2 = 65536 + 131072;

constexpr int RING_OFF = 0, RING_BYTES = 131072;
constexpr int LDSCTL_OFF = RING_BYTES, MISC_OFF = LDSCTL_OFF + 320;
constexpr int LDS_BYTES = 147456;

#define LAS __attribute__((address_space(3)))
typedef unsigned short bf16;
typedef unsigned v4u __attribute__((ext_vector_type(4)));
typedef unsigned v2u __attribute__((ext_vector_type(2)));
typedef float f32x4 __attribute__((ext_vector_type(4)));
typedef float f32x2 __attribute__((ext_vector_type(2)));
typedef float f32x16 __attribute__((ext_vector_type(16)));
typedef short bf16x8 __attribute__((ext_vector_type(8)));
#define LDS_WAIT() asm volatile("s_waitcnt lgkmcnt(0)" ::: "memory")
#define VM_WAIT() asm volatile("s_waitcnt vmcnt(0)" ::: "memory")
#define MFMA32(a, b, c) __builtin_amdgcn_mfma_f32_32x32x16_bf16((a), (b), (c), 0, 0, 0)
using pg8::pk_bf16;
__device__ __forceinline__ float bf2f(unsigned short b) { return __uint_as_float(((unsigned)b) << 16); }
__device__ __forceinline__ float bflo(unsigned w) { return __uint_as_float(w << 16); }
__device__ __forceinline__ float bfhi(unsigned w) { return __uint_as_float(w & 0xffff0000u); }
__device__ __forceinline__ unsigned short f2bf(float f) { return (unsigned short)(pk_bf16(f, 0.f) & 0xffffu); }
__device__ __forceinline__ float wave_sum(float v) {
#pragma unroll
    for (int o = 1; o < 64; o <<= 1) v += __shfl_xor(v, o);
    return v;
}
__device__ __forceinline__ int crow(int reg, int h) { return (reg & 3) + 8 * (reg >> 2) + 4 * h; }
__device__ __forceinline__ bf16x8 pack8(const f32x16& x, int s) {
    v4u p; p.x = pk_bf16(x[8 * s], x[8 * s + 1]); p.y = pk_bf16(x[8 * s + 2], x[8 * s + 3]); p.z = pk_bf16(x[8 * s + 4], x[8 * s + 5]); p.w = pk_bf16(x[8 * s + 6], x[8 * s + 7]);
    return __builtin_bit_cast(bf16x8, p);
}
#define XB_TMO      128
#define XB_XCNT(j)  (256  + 64 * (j))
#define XB_XSUB(j)  (1280 + 64 * (j))
#define XB_XGEN(j)  (2304 + 64 * (j))
#define XB_TOP      3328
#define XB_TOPGEN   3392
#define XCD_BAR_WORDS 3456
#define XB_SPIN_CAP (1u << 18)

__device__ __forceinline__ unsigned xb_ld(unsigned* p)              { return __hip_atomic_load(p, __ATOMIC_RELAXED, __HIP_MEMORY_SCOPE_AGENT); }
__device__ __forceinline__ unsigned xb_add(unsigned* p, unsigned v) { return __hip_atomic_fetch_add(p, v, __ATOMIC_RELAXED, __HIP_MEMORY_SCOPE_AGENT); }
__device__ __forceinline__ unsigned xb_xcc_id() { return (unsigned)__builtin_amdgcn_s_getreg((3 << 11) | 20) & 0xFu; }
#define XB_SPIN(cond, bar) do { unsigned _sp = 0; while (cond) { __builtin_amdgcn_s_sleep(1); \
    if ((++_sp & 255u) == 0u) { if (xb_ld(&(bar)[XB_TMO])) break; if (_sp > XB_SPIN_CAP) { atomicAdd(&(bar)[XB_TMO], 1u); break; } } } } while (0)

struct XcdBarrier {
    unsigned* bar; unsigned x;
    volatile LAS unsigned* st;
};

__device__ __forceinline__ XcdBarrier xcd_barrier_post(unsigned* bar, volatile LAS unsigned* st) {
    XcdBarrier b; b.bar = bar; b.x = xb_xcc_id(); b.st = st;
    if (threadIdx.x == 0) (void)xb_add(&bar[XB_XCNT(b.x)], 1u);
    return b;
}
__device__ __forceinline__ void xcd_barrier_complete(unsigned* bar, unsigned x, unsigned& nloc, unsigned& nx) {
    const unsigned G = gridDim.x * gridDim.y * gridDim.z;
    unsigned sum, cnt, mine, sp = 0u;
    for (;;) {
        sum = 0u; cnt = 0u; mine = 0u;
#pragma unroll
        for (unsigned j = 0; j < 16; ++j) { const unsigned c = xb_ld(&bar[XB_XCNT(j)]); sum += c; cnt += (c > 0u) ? 1u : 0u; mine = (j == x) ? c : mine; }
        if (sum == G) break;
        __builtin_amdgcn_s_sleep(1);
        if ((++sp & 255u) == 0u) { if (xb_ld(&bar[XB_TMO])) break; if (sp > XB_SPIN_CAP) { atomicAdd(&bar[XB_TMO], 1u); break; } }
    }
    nloc = mine > 0u ? mine : 1u; nx = cnt > 0u ? cnt : 1u;
}

__device__ __forceinline__ void xcd_barrier(const XcdBarrier& b) {
    asm volatile("s_waitcnt vmcnt(0)" ::: "memory");
    __syncthreads();
    if (threadIdx.x == 0) {
        unsigned* bar = b.bar;
        __builtin_amdgcn_s_waitcnt(0);
        unsigned nloc = b.st[0], nx = b.st[1];
        if (nloc == 0u) { xcd_barrier_complete(bar, b.x, nloc, nx); b.st[0] = nloc; b.st[1] = nx; }
        const unsigned old = xb_add(&bar[XB_XSUB(b.x)], 1u);
        const unsigned gen = old / nloc;
        if (old + 1u == (gen + 1u) * nloc) {
            __builtin_amdgcn_fence(__ATOMIC_RELEASE, "agent");
            asm volatile("s_waitcnt vmcnt(0)" ::: "memory");
            const unsigned og = xb_add(&bar[XB_TOP], 1u);
            const unsigned tg = og / nx;
            if (og + 1u == (tg + 1u) * nx) xb_add(&bar[XB_TOPGEN], 1u);
            else XB_SPIN(xb_ld(&bar[XB_TOPGEN]) == tg, bar);
            __builtin_amdgcn_fence(__ATOMIC_ACQUIRE, "agent");
            xb_add(&bar[XB_XGEN(b.x)], 1u);
            asm volatile("s_waitcnt vmcnt(0)" ::: "memory");
        } else {
            XB_SPIN(xb_ld(&bar[XB_XGEN(b.x)]) == gen, bar);
            __builtin_amdgcn_fence(__ATOMIC_ACQUIRE, "agent");
            asm volatile("s_waitcnt vmcnt(0)" ::: "memory");
        }
    }
    __syncthreads();
}

struct Args { const float* in[22]; float* out; unsigned char* ws; int ph_lo, ph_hi; };
struct Frame {
    LAS unsigned char* lds;
    int tid, lane, wave, G, vcu;
    unsigned char* ws; float* out;
};

struct TItem { const float* W; bf16* WT; int K, N, k0, n0, drow0; };
__device__ __forceinline__ void titem_load(const TItem& t, float (&v)[32], int lane) {
    const float* p = t.W + (size_t)(t.k0 + (lane >> 5)) * t.N + t.n0 + (lane & 31);
#pragma unroll
    for (int i = 0; i < 32; ++i) v[i] = __builtin_nontemporal_load(p + (size_t)(2 * i) * t.N);
}
__device__ __forceinline__ void titem_store(const TItem& t, const float (&v)[32], LAS float* scr, int lane) {
#pragma unroll
    for (int i = 0; i < 32; ++i) scr[(2 * i + (lane >> 5)) * 33 + (lane & 31)] = v[i];
    LDS_WAIT(); asm volatile("" ::: "memory");
    const int c = lane & 7;
#pragma unroll
    for (int j = 0; j < 4; ++j) { const int n = (lane >> 3) + 8 * j; const LAS float* s = scr + (8 * c) * 33 + n;
        v4u o; o.x = pk_bf16(s[0 * 33], s[1 * 33]); o.y = pk_bf16(s[2 * 33], s[3 * 33]); o.z = pk_bf16(s[4 * 33], s[5 * 33]); o.w = pk_bf16(s[6 * 33], s[7 * 33]);
        *(v4u*)(t.WT + (size_t)(t.drow0 + n) * t.K + t.k0 + 8 * c) = o; }
    LDS_WAIT(); asm volatile("" ::: "memory");
}
__device__ __forceinline__ void rms_row_to_bf16(const float* xrow, const float* w, bf16* orow, int lane) {
    const f32x4* xr = (const f32x4*)xrow + lane; const f32x4* wr = (const f32x4*)w + lane;
    f32x4 v[16]; float s = 0.f;
#pragma unroll
    for (int j = 0; j < 16; ++j) { v[j] = xr[64 * j]; s += (v[j].x * v[j].x + v[j].y * v[j].y) + (v[j].z * v[j].z + v[j].w * v[j].w); }
    const float rstd = 1.0f / sqrtf(wave_sum(s) * (1.0f / D) + EPS);
    v2u* o8 = (v2u*)orow + lane;
#pragma unroll
    for (int j = 0; j < 16; ++j) { const f32x4 g = wr[64 * j]; v2u o; o.x = pk_bf16(v[j].x * rstd * g.x, v[j].y * rstd * g.y); o.y = pk_bf16(v[j].z * rstd * g.z, v[j].w * rstd * g.w); o8[64 * j] = o; }
}
__device__ __forceinline__ void norm_phase(const Frame& F, const float* lo, const float* hi, const float* w, bf16* XN, int nrows, int nzero_to) {
    const int gw = F.vcu * NWAVES + F.wave, NGW = F.G * NWAVES;
    for (int r = gw; r < nrows; r += NGW) rms_row_to_bf16(r < SEQ ? lo + (size_t)r * D : hi + (size_t)(r - SEQ) * D, w, XN + (size_t)r * D, F.lane);
    for (int r = nrows + gw; r < nzero_to; r += NGW) { v4u* o = (v4u*)(XN + (size_t)r * D) + F.lane;
#pragma unroll
        for (int j = 0; j < 8; ++j) o[64 * j] = (v4u){0u, 0u, 0u, 0u}; }
}
__device__ const float ROPE_INVF[32] = {1.000000000e+00f, 7.498942018e-01f, 5.623413324e-01f, 4.216965139e-01f, 3.162277639e-01f, 2.371373922e-01f, 1.778279394e-01f, 1.333521456e-01f, 1.000000015e-01f, 7.498941571e-02f, 5.623412877e-02f, 4.216964915e-02f, 3.162277862e-02f, 2.371373586e-02f, 1.778279431e-02f, 1.333521493e-02f, 9.999999776e-03f, 7.498942316e-03f, 5.623413250e-03f, 4.216964822e-03f, 3.162277862e-03f, 2.371373819e-03f, 1.778279431e-03f, 1.333521446e-03f, 1.000000047e-03f, 7.498941850e-04f, 5.623413017e-04f, 4.216965463e-04f, 3.162277862e-04f, 2.371373848e-04f, 1.778279402e-04f, 1.333521504e-04f};
__device__ __forceinline__ void sincos_d(double a, float& c, float& s) {
    const double TWO_OVER_PI = 0.63661977236758134308, PIO2_HI = 1.57079632673412561417, PIO2_LO = 6.07710050650619224932e-11;
    const double q = __builtin_rint(a * TWO_OVER_PI); const double r = (a - q * PIO2_HI) - q * PIO2_LO; const int qi = (int)q & 3;
    const double r2 = r * r;
    const double sp = r * (1.0 + r2 * (-1.0 / 6 + r2 * (1.0 / 120 + r2 * (-1.0 / 5040 + r2 * (1.0 / 362880 + r2 * (-1.0 / 39916800 + r2 * (1.0 / 6227020800.0)))))));
    const double cp = 1.0 + r2 * (-0.5 + r2 * (1.0 / 24 + r2 * (-1.0 / 720 + r2 * (1.0 / 40320 + r2 * (-1.0 / 3628800 + r2 * (1.0 / 479001600.0 + r2 * (-1.0 / 87178291200.0)))))));
    const double sv = (qi == 0) ? sp : (qi == 1) ? cp : (qi == 2) ? -sp : -cp;
    const double cv = (qi == 0) ? cp : (qi == 1) ? -sp : (qi == 2) ? -cp : sp;
    c = (float)cv; s = (float)sv;
}
constexpr int KB_D = D / 64, KB_F = DFF / 64;
constexpr long I_GU = (long)KB_D * (DFF / 32), I_DN = (long)KB_F * (D / 32);
constexpr long I_IN = (long)KB_D * (INC / 32), I_UQ = (long)(QL / 64) * (3072 / 32), I_UKV = (long)(KVL / 64) * (4096 / 32), I_OUT = (long)KB_D * (D / 32);
constexpr long NITEMS = 4 * I_GU + 2 * I_DN + I_IN + I_UQ + I_UKV + I_OUT;
__device__ __forceinline__ void titem_decode(const Args& A, unsigned char* ws, long r, TItem& t) {
        if (r < 4 * I_GU) {
            const int which = (int)(r / I_GU); const int q = (int)(r % I_GU); const int nb = q % (DFF / 32), kb = q / (DFF / 32), n0 = nb * 32;
            const float* w4 = A.in[4]; const float* w5 = A.in[5]; const float* w18 = A.in[18]; const float* w19 = A.in[19]; t.W = which == 0 ? w4 : which == 1 ? w5 : which == 2 ? w18 : w19;     t.WT = (bf16*)(ws + (which < 2 ? WS_W1GU : WS_W2GU)); t.K = D; t.N = DFF; t.k0 = kb * 64; t.n0 = n0;
            t.drow0 = 256 * (n0 >> 7) + (n0 & 127) + ((which & 1) ? 128 : 0); return; }
        r -= 4 * I_GU;
        if (r < 2 * I_DN) { const int which = (int)(r / I_DN); const int q = (int)(r % I_DN); const int nb = q % (D / 32), kb = q / (D / 32);
            const float* w20 = A.in[20]; const float* w6 = A.in[6]; t.W = which ? w20 : w6; t.WT = (bf16*)(ws + (which ? WS_W2D : WS_W1D)); t.K = DFF; t.N = D; t.k0 = kb * 64; t.n0 = nb * 32; t.drow0 = nb * 32; return; }
        r -= 2 * I_DN;
        if (r < I_IN) { const int q = (int)r; const int nb = q % (INC / 32), kb = q / (INC / 32); t.W = A.in[8]; t.WT = (bf16*)(ws + WS_WIN); t.K = D; t.N = INC; t.k0 = kb * 64; t.n0 = nb * 32; t.drow0 = nb * 32; return; }
        r -= I_IN;
        if (r < I_UQ) { const int q = (int)r; const int nb = q % (3072 / 32), kb = q / (3072 / 32); t.W = A.in[11]; t.WT = (bf16*)(ws + WS_WUQ); t.K = QL; t.N = 3072; t.k0 = kb * 64; t.n0 = nb * 32; t.drow0 = nb * 32; return; }
        r -= I_UQ;
        if (r < I_UKV) { const int q = (int)r; const int nb = q % (4096 / 32), kb = q / (4096 / 32); t.W = A.in[13]; t.WT = (bf16*)(ws + WS_WUKV); t.K = KVL; t.N = 4096; t.k0 = kb * 64; t.n0 = nb * 32; t.drow0 = nb * 32; return; }
        r -= I_UKV;
        { const int q = (int)r; const int nb = q % (D / 32), kb = q / (D / 32); t.W = A.in[16]; t.WT = (bf16*)(ws + WS_WOUT); t.K = D; t.N = D; t.k0 = kb * 64; t.n0 = nb * 32; t.drow0 = nb * 32; }
}
__device__ __forceinline__ void p0_prologue(const Frame& F, const Args& A) {
    unsigned char* ws = F.ws;
    LAS float* scr = (LAS float*)(F.lds + RING_OFF + F.wave * 16384);
    const int gw = F.vcu * NWAVES + F.wave, NGW = F.G * NWAVES;
    if (gw < NITEMS) {
        TItem cur, nxt; float va[32], vb[32];
        titem_decode(A, ws, gw, cur); titem_load(cur, va, F.lane);
        for (long it = gw; it < NITEMS; it += 2 * NGW) {
            const bool h1 = it + NGW < NITEMS; if (h1) { titem_decode(A, ws, it + NGW, nxt); titem_load(nxt, vb, F.lane); }
            titem_store(cur, va, scr, F.lane);
            if (!h1) break;
            const bool h2 = it + 2 * NGW < NITEMS; if (h2) { titem_decode(A, ws, it + 2 * NGW, cur); titem_load(cur, va, F.lane); }
            titem_store(nxt, vb, scr, F.lane);
            if (!h2) break;
        }
    }
    { v4u* z = (v4u*)(ws + WS_WIN + (size_t)INC * D * 2); const size_t n16 = (size_t)(INCP - INC) * D * 2 / 16;
      for (size_t i = (size_t)F.vcu * 512 + F.tid; i < n16; i += (size_t)F.G * 512) z[i] = (v4u){0u, 0u, 0u, 0u}; }
    { float* HM = (float*)(ws + WS_HM); const float* meta = A.in[1];
      for (int i = F.vcu * 512 + F.tid; i < 256 * D; i += F.G * 512) HM[i] = (i < NMETA * D) ? meta[i] : 0.f; }
    norm_phase(F, A.in[0], A.in[1], A.in[3], (bf16*)(ws + AR_XN), LTOT, MP);
    { float* g1 = (float*)(ws + WS_G1); float* g2 = (float*)(ws + WS_G2); for (int i = F.vcu * 512 + F.tid; i < D; i += F.G * 512) { g1[i] = A.in[7][i]; g2[i] = A.in[17][i]; } }
    { float* lb = (float*)(ws + WS_LB); const float* lp = A.in[2];
      for (int i = F.vcu * 512 + F.tid; i < HGW; i += F.G * 512) { const float a = lp[i], b = lp[HGW + i], m = fmaxf(a, b); const float ea = expf(a - m), eb = expf(b - m); lb[i] = ea / (ea + eb); } }
    { float* ct = (float*)(ws + WS_COS); float* st = (float*)(ws + WS_SIN);
      for (int i = F.vcu * 512 + F.tid; i < LTOT * 32; i += F.G * 512) { const int pos = i >> 5, k = i & 31;
          const float invf = ROPE_INVF[k];
          const float ang = (float)pos * invf; float c, s; sincos_d((double)ang, c, s); ct[i] = c; st[i] = s; } }
}
__device__ __forceinline__ void zero_null_rows(const Frame& F) {
    float* LOGF = (float*)(F.ws + AR_LOGF); unsigned* HVw = (unsigned*)(F.ws + AR_HV);
    for (int i = F.vcu * 512 + F.tid; i < 48 * HGW; i += F.G * 512) { LOGF[i] = 0.f; if (i < 48 * HGW / 2) HVw[i] = 0u; }
}
__device__ __forceinline__ void final_norm(const Frame& F, const float* w) {
    const int gw = F.vcu * NWAVES + F.wave, NGW = F.G * NWAVES;
    int lane = F.lane; asm volatile("" : "+v"(lane));
    for (int r = gw; r < SEQ; r += NGW) {
        f32x4* xr = (f32x4*)(F.out + (size_t)r * D) + lane; const f32x4* wr = (const f32x4*)w + lane;
        f32x4 v[16]; float s = 0.f;
#pragma unroll
        for (int j = 0; j < 16; ++j) { v[j] = xr[64 * j]; s += (v[j].x * v[j].x + v[j].y * v[j].y) + (v[j].z * v[j].z + v[j].w * v[j].w); }
        const float rstd = 1.0f / sqrtf(wave_sum(s) * (1.0f / D) + EPS);
#pragma unroll
        for (int j = 0; j < 16; ++j) { const f32x4 g = wr[64 * j]; xr[64 * j] = v[j] * rstd * g; }
    }
}

__device__ __forceinline__ void meta_down_phase(const Frame& F, const bf16* ACT, const bf16* WT, float* HM, float scale, bf16* XB, float* stat, const float* gain) {
    typedef float f32x4_ __attribute__((ext_vector_type(4)));
    LAS float* red = (LAS float*)(F.lds + RING_OFF);
    const int i = F.lane & 15, kq = F.lane >> 4;
    for (int cb = F.vcu; cb < D / 16; cb += F.G) {
        const bf16* ap = ACT + (size_t)(SEQ + i) * DFF + F.wave * 1376 + 8 * kq;
        const bf16* bp = WT + (size_t)(16 * cb + i) * DFF + F.wave * 1376 + 8 * kq;
        f32x4_ acc = {0.f, 0.f, 0.f, 0.f};
#pragma unroll 8
        for (int s = 0; s < 43; ++s) { const bf16x8 a = *(const bf16x8*)(ap + 32 * s); const bf16x8 b = *(const bf16x8*)(bp + 32 * s); acc = __builtin_amdgcn_mfma_f32_16x16x32_bf16(a, b, acc, 0, 0, 0); }
#pragma unroll
        for (int j = 0; j < 4; ++j) red[F.wave * 256 + (4 * kq + j) * 16 + i] = acc[j];
        __syncthreads();
        if (F.tid < 256) { float s = 0.f;
#pragma unroll
            for (int w = 0; w < 8; ++w) s += red[w * 256 + F.tid];
            const int row = F.tid >> 4, col = 16 * cb + (F.tid & 15); const float v = HM[(size_t)row * D + col] + scale * s; HM[(size_t)row * D + col] = v;
            XB[(size_t)(SEQ + row) * D + col] = f2bf(v * gain[col]); float q = v * v; q += __shfl_xor(q, 1); q += __shfl_xor(q, 2); q += __shfl_xor(q, 4); q += __shfl_xor(q, 8); if ((F.tid & 15) == 0) atomicAdd(stat + SEQ + row, q); }
        __syncthreads();
    }
}
template <int N>
__device__ __forceinline__ void lat_norm(const Frame& F, const bf16* src, const float* w, bf16* dst, int nvalid, int ntotal) {
    constexpr int PER = N / 64;
    const int gw = F.vcu * NWAVES + F.wave, NGW = F.G * NWAVES;
    for (int r = gw; r < ntotal; r += NGW) {
        unsigned xw[PER / 2]; float x[PER]; float s = 0.f;
        if (r < nvalid) {
#pragma unroll
            for (int j = 0; j < PER / 8; ++j) { const v4u t = *((const v4u*)(src + (size_t)r * N + F.lane * PER) + j); xw[4 * j] = t.x; xw[4 * j + 1] = t.y; xw[4 * j + 2] = t.z; xw[4 * j + 3] = t.w; }
#pragma unroll
            for (int j = 0; j < PER / 2; ++j) { x[2 * j] = bflo(xw[j]); x[2 * j + 1] = bfhi(xw[j]); s += x[2 * j] * x[2 * j] + x[2 * j + 1] * x[2 * j + 1]; }
            const float rstd = 1.0f / sqrtf(wave_sum(s) * (1.0f / N) + EPS);
#pragma unroll
            for (int j = 0; j < PER / 8; ++j) { const f32x4 g0 = *(const f32x4*)(w + F.lane * PER + 8 * j), g1 = *(const f32x4*)(w + F.lane * PER + 8 * j + 4);
                v4u o; o.x = pk_bf16(x[8 * j] * rstd * g0.x, x[8 * j + 1] * rstd * g0.y); o.y = pk_bf16(x[8 * j + 2] * rstd * g0.z, x[8 * j + 3] * rstd * g0.w);
                o.z = pk_bf16(x[8 * j + 4] * rstd * g1.x, x[8 * j + 5] * rstd * g1.y); o.w = pk_bf16(x[8 * j + 6] * rstd * g1.z, x[8 * j + 7] * rstd * g1.w);
                *((v4u*)(dst + (size_t)r * N + F.lane * PER) + j) = o; }
        } else {
#pragma unroll
            for (int j = 0; j < PER / 8; ++j) *((v4u*)(dst + (size_t)r * N + F.lane * PER) + j) = (v4u){0u, 0u, 0u, 0u};
        }
    }
}

__device__ __forceinline__ void hgrn_cumsum8(const f32x2 (&g)[8], f32x2 (&c)[8]) { c[0] = g[0];
#pragma unroll
    for (int i = 1; i < 8; ++i) c[i] = c[i - 1] + g[i]; }

__device__ __forceinline__ void hgrn_pass_a(const Frame& F) {
    const float* LOGF = (const float*)(F.ws + AR_LOGF); const unsigned* HVw = (const unsigned*)(F.ws + AR_HV);
    bf16* SU = (bf16*)(F.ws + AR_SU); float* AC = (float*)(F.ws + AR_AC);
    LAS unsigned char* KDT = F.lds + RING_OFF; LAS unsigned char* VTT = F.lds + RING_OFF + 16384; LAS float* SEGT = (LAS float*)(F.lds + RING_OFF + 32768);
    const int c2 = F.lane, seg = F.wave, hh = F.lane >> 5, l31 = F.lane & 31;
    f32x2 gn[8]; unsigned vn[8];
#define HA_FETCH(it_) do { const int cc_ = (it_) >> 4, h_ = (it_) & 15; _Pragma("unroll") for (int i = 0; i < 8; ++i) { const size_t row = (size_t)(64 * cc_ + 8 * seg + i); \
        gn[i] = *(const f32x2*)(LOGF + row * HGW + h_ * HD + 2 * c2); vn[i] = HVw[(row * HGW + h_ * HD + 2 * c2) >> 1]; } } while (0)
    if (F.vcu < NCH * NH) HA_FETCH(F.vcu);
    for (int item = F.vcu; item < NCH * NH; item += F.G) {
        const int cc = item >> 4, h = item & 15;
        f32x2 g[8], c[8]; unsigned vw[8];
#pragma unroll
        for (int i = 0; i < 8; ++i) { g[i] = gn[i]; vw[i] = vn[i]; }
        if (item + F.G < NCH * NH) HA_FETCH(item + F.G);
        hgrn_cumsum8(g, c);
        *(LAS f32x2*)(SEGT + seg * 128 + 2 * c2) = c[7];
        __syncthreads();
        f32x2 off = {0.f, 0.f}, tot = {0.f, 0.f};
#pragma unroll
        for (int s = 0; s < 8; ++s) { const f32x2 t = *(const LAS f32x2*)(SEGT + s * 128 + 2 * c2); tot += t; if (s < seg) off += t; }
        float k0[8], k1[8];
#pragma unroll
        for (int i = 0; i < 8; ++i) { const f32x2 b = off + c[i];
            k0[i] = (1.0f - __expf(g[i].x)) * __expf(tot.x - b.x); k1[i] = (1.0f - __expf(g[i].y)) * __expf(tot.y - b.y); }
        const int sw = ((seg ^ (c2 & 7)) << 4);
        { v4u p; p.x = pk_bf16(k0[0], k0[1]); p.y = pk_bf16(k0[2], k0[3]); p.z = pk_bf16(k0[4], k0[5]); p.w = pk_bf16(k0[6], k0[7]); *(LAS v4u*)(KDT + (2 * c2) * 128 + sw) = p;
          v4u q; q.x = pk_bf16(k1[0], k1[1]); q.y = pk_bf16(k1[2], k1[3]); q.z = pk_bf16(k1[4], k1[5]); q.w = pk_bf16(k1[6], k1[7]); *(LAS v4u*)(KDT + (2 * c2 + 1) * 128 + sw) = q; }
        { v4u p, q;
          p.x = (vw[0] & 0xffffu) | (vw[1] << 16); p.y = (vw[2] & 0xffffu) | (vw[3] << 16); p.z = (vw[4] & 0xffffu) | (vw[5] << 16); p.w = (vw[6] & 0xffffu) | (vw[7] << 16);
          q.x = (vw[0] >> 16) | (vw[1] & 0xffff0000u); q.y = (vw[2] >> 16) | (vw[3] & 0xffff0000u); q.z = (vw[4] >> 16) | (vw[5] & 0xffff0000u); q.w = (vw[6] >> 16) | (vw[7] & 0xffff0000u);
          *(LAS v4u*)(VTT + (2 * c2) * 128 + sw) = p; *(LAS v4u*)(VTT + (2 * c2 + 1) * 128 + sw) = q; }
        if (seg == 7) { f32x2 a; a.x = __expf(tot.x); a.y = __expf(tot.y); *(f32x2*)(AC + (size_t)item * HD + 2 * c2) = a; }
        __syncthreads();
        const int dvb = F.wave & 3, dkb0 = 2 * (F.wave >> 2);
        bf16x8 vf[4];
        { const int dv = dvb * 32 + l31;
#pragma unroll
          for (int ks = 0; ks < 4; ++ks) vf[ks] = *(const LAS bf16x8*)(VTT + dv * 128 + (((2 * ks + hh) ^ ((dv >> 1) & 7)) << 4)); }
#pragma unroll
        for (int q = 0; q < 2; ++q) {
            const int dk = (dkb0 + q) * 32 + l31; f32x16 acc;
#pragma unroll
            for (int i = 0; i < 16; ++i) acc[i] = 0.f;
#pragma unroll
            for (int ks = 0; ks < 4; ++ks) { const bf16x8 kf = *(const LAS bf16x8*)(KDT + dk * 128 + (((2 * ks + hh) ^ ((dk >> 1) & 7)) << 4)); acc = MFMA32(kf, vf[ks], acc); }
            bf16* dst = SU + (size_t)item * (HD * HD) + (size_t)(dvb * 32 + l31) * HD + (dkb0 + q) * 32 + 4 * hh;
#pragma unroll
            for (int g4 = 0; g4 < 4; ++g4) { v2u o; o.x = pk_bf16(acc[4 * g4], acc[4 * g4 + 1]); o.y = pk_bf16(acc[4 * g4 + 2], acc[4 * g4 + 3]); *(v2u*)(dst + 8 * g4) = o; }
        }
    }
    __syncthreads();
#undef HA_FETCH
}

__device__ __forceinline__ void hgrn_pass_b(const Frame& F) {
    unsigned* SUw = (unsigned*)(F.ws + AR_SU); const float* AC = (const float*)(F.ws + AR_AC);
    for (int gt = F.vcu * 512 + F.tid; gt < NH * HD * (HD / 2); gt += F.G * 512) {
        const int h = gt >> 13, rem = gt & 8191, dkp = rem & 63;
        f32x2 S = {0.f, 0.f};
#pragma unroll 8
        for (int c = 0; c < NCH; ++c) {
            const size_t it = (size_t)(c * NH + h);
            const unsigned u = SUw[it * (HD * HD / 2) + rem]; const f32x2 a = *(const f32x2*)(AC + it * HD + 2 * dkp);
            S.x = a.x * S.x + bflo(u); S.y = a.y * S.y + bfhi(u);
            SUw[it * (HD * HD / 2) + rem] = pk_bf16(S.x, S.y);
        }
    }
}

__device__ __forceinline__ void hgrn_pass_c(const Frame& F, const float* hg_norm) {
    const float* LOGF = (const float*)(F.ws + AR_LOGF); const unsigned* HVw = (const unsigned*)(F.ws + AR_HV); const unsigned* HQw = (const unsigned*)(F.ws + AR_HQ);
    const bf16* SU = (const bf16*)(F.ws + AR_SU); const bf16* G = (const bf16*)(F.ws + AR_G); bf16* MIXED = (bf16*)(F.ws + AR_MIXED);
    LAS unsigned char* QT = F.lds + RING_OFF; LAS unsigned char* QHh = F.lds + RING_OFF + 16384; LAS unsigned char* KT = F.lds + RING_OFF + 32768; LAS unsigned char* VTP = F.lds + RING_OFF + 49152;
    LAS float* SEGT = (LAS float*)(F.lds + RING_OFF + 65536); LAS float* SS = (LAS float*)(F.lds + RING_OFF + 69632);
    const int c2 = F.lane, seg = F.wave, hh = F.lane >> 5, l31 = F.lane & 31;
    f32x2 gn[8]; unsigned vn[8], qn[8];
#define HC_FETCH(it_) do { const int cc_ = ((it_) >> 4) + 1, h_ = (it_) & 15; _Pragma("unroll") for (int i = 0; i < 8; ++i) { const size_t idx = (size_t)(64 * cc_ + 8 * seg + i) * HGW + h_ * HD + 2 * c2; \
        gn[i] = *(const f32x2*)(LOGF + idx); vn[i] = HVw[idx >> 1]; qn[i] = HQw[idx >> 1]; } } while (0)
    if (F.vcu < NCH * NH) HC_FETCH(F.vcu);
    for (int item = F.vcu; item < NCH * NH; item += F.G) {
        const int cc = (item >> 4) + 1, h = item & 15;
        f32x2 g[8], c[8]; unsigned vw[8], qw[8];
#pragma unroll
        for (int i = 0; i < 8; ++i) { g[i] = gn[i]; vw[i] = vn[i]; qw[i] = qn[i]; }
        const int dvb = F.wave & 3, tb = F.wave >> 2;
        const int trow = 32 * tb + l31, dv = dvb * 32 + l31;
        bf16x8 sfr[8]; v2u gtv[4];
        { const bf16* srow = SU + (size_t)((cc - 1) * NH + h) * (HD * HD) + (size_t)dv * HD + 8 * hh;
#pragma unroll
          for (int ks = 0; ks < 8; ++ks) sfr[ks] = *(const bf16x8*)(srow + 16 * ks);
#pragma unroll
          for (int g4 = 0; g4 < 4; ++g4) gtv[g4] = *(const v2u*)(G + (size_t)(64 * (cc - 1) + trow) * HGW + h * HD + dvb * 32 + 8 * g4 + 4 * hh); }
        hgrn_cumsum8(g, c);
        *(LAS f32x2*)(SEGT + seg * 128 + 2 * c2) = c[7];
        __syncthreads();
        f32x2 off = {0.f, 0.f}, bmid = {0.f, 0.f};
#pragma unroll
        for (int s = 0; s < 4; ++s) { const f32x2 t = *(const LAS f32x2*)(SEGT + s * 128 + 2 * c2); bmid += t; if (s < seg) off += t; }
#pragma unroll
        for (int s = 4; s < 7; ++s) { const f32x2 t = *(const LAS f32x2*)(SEGT + s * 128 + 2 * c2); if (s < seg) off += t; }
#pragma unroll
        for (int i = 0; i < 8; ++i) {
            const int t = 8 * seg + i; const f32x2 b = off + c[i]; const float q0 = bflo(qw[i]), q1 = bfhi(qw[i]);
            const unsigned qh = pk_bf16(q0 * __expf(b.x), q1 * __expf(b.y));
            const unsigned qt = pk_bf16(q0 * __expf(b.x - bmid.x), q1 * __expf(b.y - bmid.y));
            const unsigned kt = pk_bf16((1.0f - __expf(g[i].x)) * __expf(bmid.x - b.x), (1.0f - __expf(g[i].y)) * __expf(bmid.y - b.y));
            const int o = t * 256 + ((((c2 >> 2) ^ (t & 15))) << 4) + ((c2 & 3) << 2);
            *(LAS unsigned*)(QHh + o) = qh; *(LAS unsigned*)(QT + o) = qt; *(LAS unsigned*)(KT + o) = kt;
        }
        {
          const int sb = seg >> 2, stp = (seg >> 1) & 1, chunk0 = sb * 4 + stp * 2, bo = (seg & 1) << 3, sz = c2 & 7;
          v2u a0, a1, b0, b1;
          a0.x = (vw[0] & 0xffffu) | (vw[1] << 16); a0.y = (vw[2] & 0xffffu) | (vw[3] << 16); b0.x = (vw[4] & 0xffffu) | (vw[5] << 16); b0.y = (vw[6] & 0xffffu) | (vw[7] << 16);
          a1.x = (vw[0] >> 16) | (vw[1] & 0xffff0000u); a1.y = (vw[2] >> 16) | (vw[3] & 0xffff0000u); b1.x = (vw[4] >> 16) | (vw[5] & 0xffff0000u); b1.y = (vw[6] >> 16) | (vw[7] & 0xffff0000u);
          *(LAS v2u*)(VTP + (2 * c2) * 128 + (((chunk0) ^ sz) << 4) + bo) = a0; *(LAS v2u*)(VTP + (2 * c2) * 128 + (((chunk0 + 1) ^ sz) << 4) + bo) = b0;
          *(LAS v2u*)(VTP + (2 * c2 + 1) * 128 + (((chunk0) ^ sz) << 4) + bo) = a1; *(LAS v2u*)(VTP + (2 * c2 + 1) * 128 + (((chunk0 + 1) ^ sz) << 4) + bo) = b1; }
        if (item + F.G < NCH * NH) HC_FETCH(item + F.G);
        __syncthreads();
        f32x16 O;
#pragma unroll
        for (int i = 0; i < 16; ++i) O[i] = 0.f;
        {
#pragma unroll
          for (int ks = 0; ks < 8; ++ks) { const bf16x8 qf = *(const LAS bf16x8*)(QHh + trow * 256 + (((2 * ks + hh) ^ (trow & 15)) << 4)); O = MFMA32(sfr[ks], qf, O); } }
#pragma unroll
        for (int sb = 0; sb < 2; ++sb) {
            if (sb <= tb) {
                f32x16 X;
#pragma unroll
                for (int i = 0; i < 16; ++i) X[i] = 0.f;
                const int srow_ = 32 * sb + l31;
#pragma unroll
                for (int ks = 0; ks < 8; ++ks) { const bf16x8 kf = *(const LAS bf16x8*)(KT + srow_ * 256 + (((2 * ks + hh) ^ (srow_ & 15)) << 4));
                    const bf16x8 qf = *(const LAS bf16x8*)(QT + trow * 256 + (((2 * ks + hh) ^ (trow & 15)) << 4)); X = MFMA32(kf, qf, X); }
                if (sb == tb) {
#pragma unroll
                    for (int i = 0; i < 16; ++i) X[i] = (crow(i, hh) <= l31) ? X[i] : 0.f; }
#pragma unroll
                for (int st = 0; st < 2; ++st) { const bf16x8 pf = pack8(X, st);
                    const bf16x8 vf = *(const LAS bf16x8*)(VTP + dv * 128 + (((sb * 4 + st * 2 + hh) ^ ((dv >> 1) & 7)) << 4)); O = MFMA32(vf, pf, O); }
            }
        }
        float ssq = 0.f;
#pragma unroll
        for (int i = 0; i < 16; ++i) ssq += O[i] * O[i];
        ssq += __shfl_xor(ssq, 32);
        if (hh == 0) SS[(tb * 4 + dvb) * 32 + l31] = ssq;
        __syncthreads();
        const float tot = (SS[(tb * 4 + 0) * 32 + l31] + SS[(tb * 4 + 1) * 32 + l31]) + (SS[(tb * 4 + 2) * 32 + l31] + SS[(tb * 4 + 3) * 32 + l31]);
        const float rstd = 1.0f / sqrtf(tot * (1.0f / HD) + EPS);
        const size_t r = (size_t)(64 * (cc - 1) + trow);
#pragma unroll
        for (int g4 = 0; g4 < 4; ++g4) { const int dv0 = dvb * 32 + 8 * g4 + 4 * hh;
            const f32x4 w = *(const f32x4*)(hg_norm + h * HD + dv0); const v2u gt = gtv[g4];
            v2u o; o.x = pk_bf16(O[4 * g4] * rstd * w.x * bflo(gt.x), O[4 * g4 + 1] * rstd * w.y * bfhi(gt.x)); o.y = pk_bf16(O[4 * g4 + 2] * rstd * w.z * bflo(gt.y), O[4 * g4 + 3] * rstd * w.w * bfhi(gt.y));
            *(v2u*)(MIXED + r * D + h * HD + dv0) = o; }
    }
    __syncthreads();
#undef HC_FETCH
}

__device__ __forceinline__ void kvprep_phase(const Frame& F, const float* kw) {
    const bf16* KVRAW = (const bf16*)(F.ws + AR_KVRAW); const bf16* KR = (const bf16*)(F.ws + AR_KR); const float* CT = (const float*)(F.ws + WS_COS); const float* ST = (const float*)(F.ws + WS_SIN);
    unsigned char* KH = F.ws + AR_KH; unsigned char* VT = F.ws + AR_VT;
    LAS unsigned char* KI = F.lds + RING_OFF;
    LAS bf16* VS = (LAS bf16*)(F.lds + RING_OFF + 24576);
    const int lane = F.lane;
    const float w0 = kw[lane], w1 = kw[64 + lane], w2 = kw[128 + lane];
    for (int item = F.vcu; item < NKT * NH; item += F.G) {
        const int t = item >> 4, h = item & 15;
#pragma unroll 2
        for (int i = 0; i < 8; ++i) {
            const int kk = 8 * F.wave + i, p = 64 * t + kk; const bool valid = p < LTOT; const int r = p < 16 ? SEQ + p : p - 16;
            float x0 = 0.f, x1 = 0.f, x2 = 0.f; unsigned vv = 0u;
            if (valid) { const bf16* src = KVRAW + (size_t)r * 4096 + h * 256; x0 = bf2f(src[lane]); x1 = bf2f(src[64 + lane]); x2 = bf2f(KR[(size_t)r * RD + lane]); vv = *(const unsigned*)(src + 128 + 2 * lane); }
            const float rstd = 1.0f / sqrtf(wave_sum(x0 * x0 + x1 * x1 + x2 * x2) * (1.0f / QKD) + EPS);
            x0 *= rstd * w0; x1 *= rstd * w1; x2 *= rstd * w2;
            const float other = __shfl_xor(x2, 32); const int pc = valid ? p : 0; const float c = CT[pc * 32 + (lane & 31)], s = ST[pc * 32 + (lane & 31)];
            x2 = (lane < 32) ? (x2 * c - other * s) : (x2 * c + other * s);
            const int sz = (kk >> 1) & 7;
#define KOFF(d) (kk * 384 + ((((d) >> 3) & ~7) << 4) + (((((d) >> 3) & 7) ^ sz) << 4) + (((d) & 7) << 1))
            *(LAS bf16*)(KI + KOFF(lane)) = f2bf(x0); *(LAS bf16*)(KI + KOFF(64 + lane)) = f2bf(x1); *(LAS bf16*)(KI + KOFF(128 + lane)) = f2bf(x2);
#undef KOFF
            *(LAS unsigned*)(VS + kk * 136 + 2 * lane) = vv;
        }
        __syncthreads();
        { v4u* dst = (v4u*)(KH + (size_t)(h * NKT + t) * 24576);
#pragma unroll
          for (int j = 0; j < 3; ++j) dst[F.tid + 512 * j] = *(const LAS v4u*)(KI + (F.tid + 512 * j) * 16); }
        { v4u* dst = (v4u*)(VT + (size_t)(h * NKT + t) * 16384);
#pragma unroll
          for (int j = 0; j < 2; ++j) { const int ch = F.tid + 512 * j, dv = ch >> 3, cpos = ch & 7, cl = cpos ^ ((dv >> 1) & 7), kb = cl >> 2, st = (cl >> 1) & 1, hh = cl & 1;
              const int k0 = 32 * kb + 16 * st + 4 * hh; unsigned short e[8];
#pragma unroll
              for (int q = 0; q < 8; ++q) e[q] = VS[(k0 + 8 * (q >> 2) + (q & 3)) * 136 + dv];
              v4u o; o.x = e[0] | ((unsigned)e[1] << 16); o.y = e[2] | ((unsigned)e[3] << 16); o.z = e[4] | ((unsigned)e[5] << 16); o.w = e[6] | ((unsigned)e[7] << 16);
              dst[ch] = o; } }
        __syncthreads();
    }
}

constexpr int ATT_KB = 24576, ATT_VB = 16384;
constexpr int ATT_VBASE = 3 * ATT_KB;
__device__ __forceinline__ void attn_issue_k(const Frame& F, const unsigned char* ktile, LAS unsigned char* buf) {
    unsigned lo = F.lane * 16; asm volatile("" : "+v"(lo));
#pragma unroll
    for (int j = 0; j < 3; ++j) __builtin_amdgcn_global_load_lds((const unsigned*)(ktile + (size_t)(F.wave * 3 + j) * 1024 + lo), (LAS unsigned*)(buf + (F.wave * 3 + j) * 1024), 16, 0, 0);
}
__device__ __forceinline__ void attn_issue_v(const Frame& F, const unsigned char* vtile, LAS unsigned char* buf) {
    unsigned lo = F.lane * 16; asm volatile("" : "+v"(lo));
#pragma unroll
    for (int j = 0; j < 2; ++j) __builtin_amdgcn_global_load_lds((const unsigned*)(vtile + (size_t)(F.wave * 2 + j) * 1024 + lo), (LAS unsigned*)(buf + (F.wave * 2 + j) * 1024), 16, 0, 0);
}
__device__ __forceinline__ float xhalf_max(float v) { const auto r = __builtin_amdgcn_permlane32_swap(__float_as_uint(v), __float_as_uint(v), false, false); return fmaxf(__uint_as_float(r[0]), __uint_as_float(r[1])); }
__device__ __forceinline__ float xhalf_sum(float v) { const auto r = __builtin_amdgcn_permlane32_swap(__float_as_uint(v), __float_as_uint(v), false, false); return __uint_as_float(r[0]) + __uint_as_float(r[1]); }

#define ATT_KLD(ks, r) (*(const LAS bf16x8*)(lds + (kbo + kof[(ks) & 3] + ((ks) >> 2) * 128 + (r) * 12288)))
#define ATT_LDK4(dst, g_) do { dst[0] = ATT_KLD(2 * (g_), 0); dst[1] = ATT_KLD(2 * (g_), 1); dst[2] = ATT_KLD(2 * (g_) + 1, 0); dst[3] = ATT_KLD(2 * (g_) + 1, 1); } while (0)
#define ATT_MMK4(src, g_) do { S0 = MFMA32(src[0], qf(2 * (g_)), S0); S1 = MFMA32(src[1], qf(2 * (g_)), S1); S0 = MFMA32(src[2], qf(2 * (g_) + 1), S0); S1 = MFMA32(src[3], qf(2 * (g_) + 1), S1); } while (0)
#define ATT_QK(t_, bcur_) do { \
    _Pragma("unroll") for (int i = 0; i < 16; ++i) { S0[i] = negM; S1[i] = negM; }     \
    if (64 * (t_) <= 16 + q0 + 31) { \
        const int kbo = (bcur_) * ATT_KB; \
        bf16x8 ka[4], kb[4], kc[4];                  \
        ATT_LDK4(ka, 0); __builtin_amdgcn_sched_barrier(0); ATT_LDK4(kb, 1); __builtin_amdgcn_sched_barrier(0); \
        ATT_LDK4(kc, 2); __builtin_amdgcn_sched_barrier(0); ATT_MMK4(ka, 0); __builtin_amdgcn_sched_barrier(0); \
        ATT_LDK4(ka, 3); __builtin_amdgcn_sched_barrier(0); ATT_MMK4(kb, 1); __builtin_amdgcn_sched_barrier(0); \
        ATT_LDK4(kb, 4); __builtin_amdgcn_sched_barrier(0); ATT_MMK4(kc, 2); __builtin_amdgcn_sched_barrier(0); \
        ATT_LDK4(kc, 5); __builtin_amdgcn_sched_barrier(0); ATT_MMK4(ka, 3); __builtin_amdgcn_sched_barrier(0); \
        ATT_MMK4(kb, 4); __builtin_amdgcn_sched_barrier(0); ATT_MMK4(kc, 5); __builtin_amdgcn_sched_barrier(0); } } while (0)

#define ATT_SMPV(t_, bcur_) do { if (64 * (t_) <= 16 + q0 + 31) { \
    if (64 * (t_) + 63 > 16 + q0) { const int dh = qpos - 64 * (t_) - 4 * hh;     \
        _Pragma("unroll") for (int i = 0; i < 16; ++i) { S0[i] = ((i & 3) + 8 * (i >> 2) <= dh) ? S0[i] : -__builtin_inff(); S1[i] = ((i & 3) + 8 * (i >> 2) + 32 <= dh) ? S1[i] : -__builtin_inff(); } } \
    float ps = 0.f; \
    _Pragma("unroll") for (int i = 0; i < 16; ++i) { S0[i] = __builtin_amdgcn_exp2f(S0[i]); S1[i] = __builtin_amdgcn_exp2f(S1[i]); ps += S0[i] + S1[i]; } \
    l_run += ps; \
    const bf16x8 p00 = pack8(S0, 0), p01 = pack8(S0, 1), p10 = pack8(S1, 0), p11 = pack8(S1, 1); \
    const int vbo = ATT_VBASE + (bcur_) * ATT_VB; \
    bf16x8 va[4], vb[4], vc[4]; \
    va[0] = ATT_VF(0, 0); va[1] = ATT_VF(0, 2); va[2] = ATT_VF(0, 4); va[3] = ATT_VF(0, 6); \
    __builtin_amdgcn_sched_barrier(0); \
    vb[0] = ATT_VF(1, 0); vb[1] = ATT_VF(1, 2); vb[2] = ATT_VF(1, 4); vb[3] = ATT_VF(1, 6); \
    __builtin_amdgcn_sched_barrier(0); \
    vc[0] = ATT_VF(2, 0); vc[1] = ATT_VF(2, 2); vc[2] = ATT_VF(2, 4); vc[3] = ATT_VF(2, 6); \
    __builtin_amdgcn_sched_barrier(0); \
    O0 = MFMA32(va[0], p00, O0); O0 = MFMA32(va[1], p01, O0); O0 = MFMA32(va[2], p10, O0); O0 = MFMA32(va[3], p11, O0); \
    __builtin_amdgcn_sched_barrier(0); \
    va[0] = ATT_VF(3, 0); va[1] = ATT_VF(3, 2); va[2] = ATT_VF(3, 4); va[3] = ATT_VF(3, 6); \
    __builtin_amdgcn_sched_barrier(0); \
    O1 = MFMA32(vb[0], p00, O1); O1 = MFMA32(vb[1], p01, O1); O1 = MFMA32(vb[2], p10, O1); O1 = MFMA32(vb[3], p11, O1); \
    __builtin_amdgcn_sched_barrier(0); \
    O2 = MFMA32(vc[0], p00, O2); O2 = MFMA32(vc[1], p01, O2); O2 = MFMA32(vc[2], p10, O2); O2 = MFMA32(vc[3], p11, O2); \
    __builtin_amdgcn_sched_barrier(0); \
    O3 = MFMA32(va[0], p00, O3); O3 = MFMA32(va[1], p01, O3); O3 = MFMA32(va[2], p10, O3); O3 = MFMA32(va[3], p11, O3); \
    __builtin_amdgcn_sched_barrier(0); } } while (0)
#define ATT_VF(dvb, c) (*(const LAS bf16x8*)(lds + (vbo + vof[(c) >> 1] + (dvb) * 4096)))
#define ATT_WAIT(n) asm volatile("s_waitcnt vmcnt(" #n ")" ::: "memory")
#define ATT_BAR() do { asm volatile("s_waitcnt lgkmcnt(0)" ::: "memory"); __builtin_amdgcn_s_barrier(); asm volatile("" ::: "memory"); } while (0)

__device__ __forceinline__ void attn_unit(const Frame& F, int h, int qb, const float* qw, float negM, bool desc) {
    unsigned char* wsl = F.ws; asm volatile("" : "+s"(wsl));
    const bf16* QRAW = (const bf16*)(wsl + AR_QRAW); const float* CT = (const float*)(wsl + WS_COS); const float* ST = (const float*)(wsl + WS_SIN);
    const unsigned char* KH = wsl + AR_KH + (size_t)h * NKT * ATT_KB; const unsigned char* VT = wsl + AR_VT + (size_t)h * NKT * ATT_VB;
    LAS unsigned char* lds = F.lds + RING_OFF;
    int lane = F.lane; asm volatile("" : "+v"(lane));
    const int hh = lane >> 5, l31 = lane & 31, sz = (l31 >> 1) & 7;
    const bool grpA = F.wave < 4;
    const int q0 = 256 * qb + 32 * F.wave;
    const int qpos = 16 + q0 + l31;
    const int nt = (256 * qb + 271) / 64 + 1;
    v4u qv[12];
#define qf(ks) (__builtin_bit_cast(bf16x8, qv[ks]))
    { const bf16* qrow = (QRAW + (size_t)q0 * 3072 + h * QKD) + (unsigned)(l31 * 3072 + 8 * hh);
#pragma unroll
      for (int ks = 0; ks < 12; ++ks) qv[ks] = *(const v4u*)(qrow + 16 * ks);
      { const int ta = desc ? nt - 1 : 0, tb2 = desc ? nt - 2 : 1;
        attn_issue_k(F, KH + (size_t)ta * ATT_KB, lds); attn_issue_v(F, VT + (size_t)ta * ATT_VB, lds + ATT_VBASE);
        attn_issue_k(F, KH + (size_t)tb2 * ATT_KB, lds + ATT_KB); attn_issue_v(F, VT + (size_t)tb2 * ATT_VB, lds + ATT_VBASE + ATT_VB); }
      float ss = 0.f;
#pragma unroll
      for (int ks = 0; ks < 12; ++ks) { const v4u w = qv[ks]; const float a0 = bflo(w.x), a1 = bfhi(w.x), a2 = bflo(w.y), a3 = bfhi(w.y), a4 = bflo(w.z), a5 = bfhi(w.z), a6 = bflo(w.w), a7 = bfhi(w.w);
          ss += (a0 * a0 + a1 * a1) + (a2 * a2 + a3 * a3) + (a4 * a4 + a5 * a5) + (a6 * a6 + a7 * a7); }
      ss = xhalf_sum(ss);
#pragma unroll
      for (int ks = 0; ks < 12; ++ks) asm volatile("" : "+v"(qv[ks]));
      const float rs = QSCALE / sqrtf(ss * (1.0f / QKD) + EPS);
#pragma unroll
      for (int ks = 0; ks < 8; ++ks) { const v4u w = qv[ks]; const f32x4 g0 = *(const f32x4*)(qw + 16 * ks + 8 * hh), g1 = *(const f32x4*)(qw + 16 * ks + 8 * hh + 4);
          v4u o; o.x = pk_bf16(bflo(w.x) * rs * g0[0], bfhi(w.x) * rs * g0[1]); o.y = pk_bf16(bflo(w.y) * rs * g0[2], bfhi(w.y) * rs * g0[3]);
          o.z = pk_bf16(bflo(w.z) * rs * g1[0], bfhi(w.z) * rs * g1[1]); o.w = pk_bf16(bflo(w.w) * rs * g1[2], bfhi(w.w) * rs * g1[3]); qv[ks] = o;
          if (ks & 1) asm volatile("" ::: "memory"); }
#pragma unroll
      for (int a = 0; a < 2; ++a) {
          const v4u w1 = qv[8 + a], w2 = qv[10 + a]; const int i0 = 16 * a + 8 * hh;
          const f32x4 ga0 = *(const f32x4*)(qw + 128 + i0), ga1 = *(const f32x4*)(qw + 128 + i0 + 4), gb0 = *(const f32x4*)(qw + 160 + i0), gb1 = *(const f32x4*)(qw + 160 + i0 + 4);
          const float* ctp = (CT + (size_t)(16 + q0) * 32 + 16 * a) + (unsigned)(l31 * 32 + 8 * hh); const float* stp = (ST + (size_t)(16 + q0) * 32 + 16 * a) + (unsigned)(l31 * 32 + 8 * hh);
          const f32x4 c0 = *(const f32x4*)ctp, c1 = *(const f32x4*)(ctp + 4), s0 = *(const f32x4*)stp, s1 = *(const f32x4*)(stp + 4);
          float x1[8] = {bflo(w1.x) * ga0[0], bfhi(w1.x) * ga0[1], bflo(w1.y) * ga0[2], bfhi(w1.y) * ga0[3], bflo(w1.z) * ga1[0], bfhi(w1.z) * ga1[1], bflo(w1.w) * ga1[2], bfhi(w1.w) * ga1[3]};
          float x2[8] = {bflo(w2.x) * gb0[0], bfhi(w2.x) * gb0[1], bflo(w2.y) * gb0[2], bfhi(w2.y) * gb0[3], bflo(w2.z) * gb1[0], bfhi(w2.z) * gb1[1], bflo(w2.w) * gb1[2], bfhi(w2.w) * gb1[3]};
          const float cc[8] = {c0[0], c0[1], c0[2], c0[3], c1[0], c1[1], c1[2], c1[3]}, sn[8] = {s0[0], s0[1], s0[2], s0[3], s1[0], s1[1], s1[2], s1[3]};
          float y1[8], y2[8];
#pragma unroll
          for (int j = 0; j < 8; ++j) { y1[j] = (x1[j] * cc[j] - x2[j] * sn[j]) * rs; y2[j] = (x2[j] * cc[j] + x1[j] * sn[j]) * rs; }
          v4u o1, o2; o1.x = pk_bf16(y1[0], y1[1]); o1.y = pk_bf16(y1[2], y1[3]); o1.z = pk_bf16(y1[4], y1[5]); o1.w = pk_bf16(y1[6], y1[7]);
          o2.x = pk_bf16(y2[0], y2[1]); o2.y = pk_bf16(y2[2], y2[3]); o2.z = pk_bf16(y2[4], y2[5]); o2.w = pk_bf16(y2[6], y2[7]);
          qv[8 + a] = o1; qv[10 + a] = o2; asm volatile("" ::: "memory"); }
    }
    int kof[4], vof[4];
#pragma unroll
    for (int c2 = 0; c2 < 4; ++c2) { const int slot = (((2 * c2 + hh) ^ sz) & 7) << 4; kof[c2] = l31 * 384 + slot; vof[c2] = l31 * 128 + slot; }
    f32x16 O0, O1, O2, O3, S0, S1;
#pragma unroll
    for (int i = 0; i < 16; ++i) { O0[i] = 0.f; O1[i] = 0.f; O2[i] = 0.f; O3[i] = 0.f; S0[i] = 0.f; S1[i] = 0.f; }
    float l_run = 0.f;
    ATT_WAIT(7); ATT_BAR();
#define ATT_TILE(i_) (desc ? nt - 1 - (i_) : (i_))
#define ATT_ISSUE_K() attn_issue_k(F, KH + (size_t)ATT_TILE((t + 2 < nt) ? t + 2 : nt - 1) * ATT_KB, lds + b2 * ATT_KB)
#define ATT_ISSUE_V() attn_issue_v(F, VT + (size_t)ATT_TILE((t + 2 < nt) ? t + 2 : nt - 1) * ATT_VB, lds + ATT_VBASE + b2 * ATT_VB)
#define ATT_ROT() do { bp = b0; b0 = (b0 == 2) ? 0 : b0 + 1; b2 = (b2 == 2) ? 0 : b2 + 1; } while (0)
    int b0 = 0, b2 = 2, bp = 2;
    if (grpA) {
#pragma unroll 1
        for (int t = 0; t < nt; ++t) {
            const int tl = ATT_TILE(t);
            ATT_ISSUE_K(); ATT_QK(tl, b0); ATT_WAIT(8); ATT_BAR();
            ATT_ISSUE_V(); ATT_SMPV(tl, b0); ATT_WAIT(7); ATT_BAR();
            ATT_ROT();
        }
    } else {
#pragma unroll 1
        for (int t = 0; t < nt; ++t) {
            const int tl = ATT_TILE(t), tlp = ATT_TILE(t - 1);
            ATT_ISSUE_K(); if (t > 0) { ATT_SMPV(tlp, bp); } ATT_WAIT(8); ATT_BAR();
            ATT_ISSUE_V(); ATT_QK(tl, b0); ATT_WAIT(7); ATT_BAR();
            ATT_ROT();
        }
        { const int tll = ATT_TILE(nt - 1); ATT_SMPV(tll, bp); }
    }
#undef ATT_ROT
#undef ATT_TILE
#undef ATT_ISSUE_K
#undef ATT_ISSUE_V
    ATT_WAIT(0); ATT_BAR();
    const float inv = 1.0f / xhalf_sum(l_run);
    bf16* orow = ((bf16*)(wsl + AR_MIXED) + (size_t)q0 * D + HGW + h * HD) + (unsigned)(l31 * D + 4 * hh);
#pragma unroll
    for (int g4 = 0; g4 < 4; ++g4) {
        v2u o;
        o.x = pk_bf16(O0[4 * g4] * inv, O0[4 * g4 + 1] * inv); o.y = pk_bf16(O0[4 * g4 + 2] * inv, O0[4 * g4 + 3] * inv); *(v2u*)(orow + 0 + 8 * g4) = o;
        o.x = pk_bf16(O1[4 * g4] * inv, O1[4 * g4 + 1] * inv); o.y = pk_bf16(O1[4 * g4 + 2] * inv, O1[4 * g4 + 3] * inv); *(v2u*)(orow + 32 + 8 * g4) = o;
        o.x = pk_bf16(O2[4 * g4] * inv, O2[4 * g4 + 1] * inv); o.y = pk_bf16(O2[4 * g4 + 2] * inv, O2[4 * g4 + 3] * inv); *(v2u*)(orow + 64 + 8 * g4) = o;
        o.x = pk_bf16(O3[4 * g4] * inv, O3[4 * g4 + 1] * inv); o.y = pk_bf16(O3[4 * g4 + 2] * inv, O3[4 * g4 + 3] * inv); *(v2u*)(orow + 96 + 8 * g4) = o;
    }
}
#undef ATT_QK
#undef qf
#undef ATT_KLD
#undef ATT_LDK4
#undef ATT_MMK4
#undef ATT_SMPV
#undef ATT_VF
#undef ATT_WAIT
#undef ATT_BAR
__device__ __forceinline__ void attn_phase(const Frame& F, const float* qw, const float* kw) {
    float gq = fmaxf(fmaxf(fabsf(qw[F.lane]), fabsf(qw[64 + F.lane])), fabsf(qw[128 + F.lane])), gk = fmaxf(fmaxf(fabsf(kw[F.lane]), fabsf(kw[64 + F.lane])), fabsf(kw[128 + F.lane]));
#pragma unroll
    for (int o = 1; o < 64; o <<= 1) { gq = fmaxf(gq, __shfl_xor(gq, o)); gk = fmaxf(gk, __shfl_xor(gk, o)); }
    const float negM = -(1.01f * 13.856406460551018f * 1.4426950408889634f) * gq * gk;
    if (F.wave >= 4) __builtin_amdgcn_s_setprio(1);
    for (int item = F.vcu; item < NH * 32; item += F.G) {
        const int h = item >> 5, pr = item & 31;
#pragma unroll 1
        for (int u = 0; u < 2; ++u) attn_unit(F, h, u ? pr : 63 - pr, qw, negM, false);
    }
    __builtin_amdgcn_s_setprio(0);
}

constexpr int N_PHASES = 14;
#ifndef WGM_GU
#define WGM_GU 8
#endif
#ifndef WGM_IN
#define WGM_IN 8
#endif
#ifndef WGM_DOWN
#define WGM_DOWN 4
#endif
#ifndef PROBE_PHASE
#define PROBE_PHASE -1
#endif
#define REP(k) for (int rep_ = 0; rep_ < ((PROBE_PHASE == (k)) ? 2 : 1); ++rep_)
#define RSCALE(k, s) ((PROBE_PHASE == (k) && rep_ == 0) ? 0.0f : (s))
__global__ void __launch_bounds__(NWAVES * 64, 2) fwd_kernel(Args args) {
    extern __shared__ __attribute__((aligned(16))) unsigned char lds_raw[];
    Frame F;
    F.lds = (LAS unsigned char*)lds_raw;
    F.tid = threadIdx.x; F.lane = F.tid & 63; F.wave = __builtin_amdgcn_readfirstlane(F.tid >> 6);
    F.G = gridDim.x; { const int bx = blockIdx.x; F.vcu = (F.G % 8 == 0) ? (bx % 8) * (F.G / 8) + bx / 8 : bx; }
    F.ws = args.ws; F.out = args.out;
    unsigned char* ws = args.ws;
    for (int u = F.tid; u < (LDS_BYTES - LDSCTL_OFF) / 4; u += NWAVES * 64) ((LAS unsigned*)(F.lds + LDSCTL_OFF))[u] = 0u;
    __syncthreads();
    XcdBarrier bar; bar.bar = (unsigned*)(ws + WS_CTL) + CW_BAR; bar.x = 0; bar.st = nullptr;
    const int lo = args.ph_lo, hi = args.ph_hi;
    if (hi - lo > 1) bar = xcd_barrier_post((unsigned*)(ws + WS_CTL) + CW_BAR, (volatile LAS unsigned*)(F.lds + MISC_OFF) + 8);
#define IN(k) (lo <= (k) && (k) < hi)
#define SEAM(k) do { if (IN(k) && IN((k) + 1)) xcd_barrier(bar); { int t_ = threadIdx.x; asm volatile("" : "+v"(t_)); F.tid = t_; F.lane = t_ & 63; } } while (0)
    float* HM = (float*)(ws + WS_HM);
    bf16* XN = (bf16*)(ws + AR_XN); bf16* ACT = (bf16*)(ws + AR_ACT);

    float* STAT1 = (float*)(ws + WS_CTL + CTL_STAT1); float* STAT2 = (float*)(ws + WS_CTL + CTL_STAT2);

    if (IN(0)) REP(0) { p0_prologue(F, args); __syncthreads(); } SEAM(0);

    if (IN(1)) REP(1) {
        pg8::Gemm g{XN, (const bf16*)(ws + WS_W1GU), MP, 2 * DFF, D}; pg8::StaticOrder S; S.init(MP, 2 * DFF, F.G, (int)blockIdx.x, WGM_GU);
        pg8::EpiSwiglu<false> E{ACT, DFF, nullptr};
        pg8::gemm_phase<pg8::EpiSwiglu<false>, pg8::StaticOrder, true, true>(F.lds + RING_OFF, g, S, E);
    } SEAM(1);

    if (IN(2)) {
        pg8::Gemm g{ACT, (const bf16*)(ws + WS_W1D), SEQ, D, DFF}; pg8::StaticOrder S; S.init(SEQ, D, F.G, (int)blockIdx.x, WGM_DOWN);
        typedef pg8::EpiResid<true, AR_XN, WS_CTL + CTL_STAT1, WS_G1> Epi; Epi E{args.in[0], F.out, D, 0.5f, ws};
        pg8::gemm_phase<Epi, pg8::StaticOrder, true, true>(F.lds + RING_OFF, g, S, E);
        meta_down_phase(F, ACT, (const bf16*)(ws + WS_W1D), HM, 0.5f, XN, STAT1, (const float*)(ws + WS_G1));
    } SEAM(2);

    if (IN(3)) REP(3) {
        zero_null_rows(F);
        pg8::Gemm g{XN, (const bf16*)(ws + WS_WIN), MP, INCP, D}; pg8::StaticOrder S; S.init(MP, INCP, F.G, (int)blockIdx.x, WGM_IN);
        pg8::EpiWin E{(bf16*)(ws + AR_HQ), (bf16*)(ws + AR_HV), (bf16*)(ws + AR_G), (bf16*)(ws + AR_CQ), (bf16*)(ws + AR_CKV), (bf16*)(ws + AR_KR), (float*)(ws + AR_LOGF), (const float*)(ws + WS_LB), STAT1};
        pg8::gemm_phase<pg8::EpiWin, pg8::StaticOrder, true, true>(F.lds + RING_OFF, g, S, E);
    } SEAM(3);

    if (IN(4)) REP(4) {
        lat_norm<QL>(F, (const bf16*)(ws + AR_CQ), args.in[10], (bf16*)(ws + AR_CQN), LTOT, MP);
        lat_norm<KVL>(F, (const bf16*)(ws + AR_CKV), args.in[12], (bf16*)(ws + AR_CKVN), LTOT, MP);
        hgrn_pass_a(F);
    } SEAM(4);

    if (IN(5)) { hgrn_pass_b(F); } SEAM(5);
    if (IN(6)) REP(6) { hgrn_pass_c(F, args.in[9]); } SEAM(6);

    if (IN(7)) REP(7) {
        { pg8::Gemm g{(const bf16*)(ws + AR_CQN), (const bf16*)(ws + WS_WUQ), SEQ, 3072, QL}; pg8::StaticOrder S; S.init(SEQ, 3072, F.G, (int)blockIdx.x);
          pg8::EpiPlain E{(bf16*)(ws + AR_QRAW), 3072};
          pg8::gemm_phase<pg8::EpiPlain, pg8::StaticOrder, true, true>(F.lds + RING_OFF, g, S, E); }
        { pg8::Gemm g{(const bf16*)(ws + AR_CKVN), (const bf16*)(ws + WS_WUKV), MP, 4096, KVL}; pg8::StaticOrder S; S.init(MP, 4096, F.G, (int)blockIdx.x);
          pg8::EpiPlain E{(bf16*)(ws + AR_KVRAW), 4096};
          pg8::gemm_phase<pg8::EpiPlain, pg8::StaticOrder, true, true>(F.lds + RING_OFF, g, S, E); }
    } SEAM(7);

    if (IN(8)) REP(8) { kvprep_phase(F, args.in[15]); } SEAM(8);

    if (IN(9)) { attn_phase(F, args.in[14], args.in[15]); if (PROBE_PHASE == 9) attn_phase(F, args.in[14], args.in[15]); } SEAM(9);

    if (IN(10)) {
        pg8::Gemm g{(const bf16*)(ws + AR_MIXED), (const bf16*)(ws + WS_WOUT), SEQ, D, D}; pg8::StaticOrder S; S.init(SEQ, D, F.G, (int)blockIdx.x, WGM_DOWN);
        typedef pg8::EpiResid<true, AR_XN2, WS_CTL + CTL_STAT2, WS_G2> Epi; Epi E{F.out, F.out, D, 1.0f, ws};
        pg8::gemm_phase<Epi, pg8::StaticOrder, true, true>(F.lds + RING_OFF, g, S, E);
    } SEAM(10);

    if (IN(11)) REP(11) {
        pg8::Gemm g{(const bf16*)(ws + AR_XN2), (const bf16*)(ws + WS_W2GU), SEQ, 2 * DFF, D}; pg8::StaticOrder S; S.init(SEQ, 2 * DFF, F.G, (int)blockIdx.x, WGM_GU);
        pg8::EpiSwiglu<true> E{ACT, DFF, STAT2};
        pg8::gemm_phase<pg8::EpiSwiglu<true>, pg8::StaticOrder, true, true>(F.lds + RING_OFF, g, S, E);
    } SEAM(11);

    if (IN(12)) {
        pg8::Gemm g{ACT, (const bf16*)(ws + WS_W2D), SEQ, D, DFF}; pg8::StaticOrder S; S.init(SEQ, D, F.G, (int)blockIdx.x, WGM_DOWN);
        typedef pg8::EpiResid<false, 0, 0, 0> Epi; Epi E{F.out, F.out, D, 0.5f, ws};
        pg8::gemm_phase<Epi, pg8::StaticOrder, true, true>(F.lds + RING_OFF, g, S, E);
    } SEAM(12);

    if (IN(13)) { final_norm(F, args.in[21]); }
#undef IN
#undef SEAM
}

extern "C" void kernel_launch(void* const* d_in, const int* in_sizes, int n_in, void* d_out, int out_size, void* d_ws, size_t ws_size, hipStream_t stream) {
    static int grid = 0;
    if (grid == 0) {
        if (n_in != 22 || out_size != SEQ * D || ws_size < WS_END) { fprintf(stderr, "kernel_launch: unexpected shapes (n_in %d, out %d, ws %zu < %zu)\n", n_in, out_size, ws_size, (size_t)WS_END); grid = -1; return; }
        int dev = 0, cus = 0, per_cu = 0;
        if (hipGetDevice(&dev) != hipSuccess || hipDeviceGetAttribute(&cus, hipDeviceAttributeMultiprocessorCount, dev) != hipSuccess) { grid = -1; return; }
        if (hipFuncSetAttribute((const void*)fwd_kernel, hipFuncAttributeMaxDynamicSharedMemorySize, LDS_BYTES) != hipSuccess) { fprintf(stderr, "kernel_launch: hipFuncSetAttribute failed\n"); grid = -1; return; }
        if (hipOccupancyMaxActiveBlocksPerMultiprocessor(&per_cu, (const void*)fwd_kernel, NWAVES * 64, LDS_BYTES) != hipSuccess || per_cu < 1) fprintf(stderr, "kernel_launch: occupancy query says %d\n", per_cu);
        (void)hipGetLastError();
        grid = cus;
    }
    if (grid < 0) return;
    if (hipMemsetAsync((char*)d_ws + WS_CTL, 0, CTL_ZERO_BYTES, stream) != hipSuccess) return;
    Args a{};
    for (int i = 0; i < 22; ++i) a.in[i] = (const float*)d_in[i];
    a.out = (float*)d_out; a.ws = (unsigned char*)d_ws;
#if MK_SINGLE
    a.ph_lo = 0; a.ph_hi = N_PHASES;
    hipLaunchKernelGGL(fwd_kernel, dim3(grid), dim3(NWAVES * 64), LDS_BYTES, stream, a);
#else
    for (int p = 0; p < N_PHASES; ++p) { a.ph_lo = p; a.ph_hi = p + 1; hipLaunchKernelGGL(fwd_kernel, dim3(grid), dim3(NWAVES * 64), LDS_BYTES, stream, a); }
#endif
}
```

```cpp
#include <hip/hip_runtime.h>
#include <cstdio>
#include <cstdint>
#ifndef MK_SINGLE
#define MK_SINGLE 1
#endif
namespace pg8 {
#define PG8_LAS __attribute__((address_space(3)))
typedef unsigned short bf16_t;
typedef short bf16x8 __attribute__((ext_vector_type(8)));
typedef float f32x4 __attribute__((ext_vector_type(4)));
typedef unsigned u32x4 __attribute__((ext_vector_type(4)));
constexpr int BM = 256, BK = 64, HALF = 128, HTB = HALF * BK * 2  , STAGE_BYTES = 8 * HTB, NXCD = 8, WGM = 8;

__host__ __device__ __forceinline__ int lds_byte(int r, int c) { const int st = (r >> 4) * 2 + (c >> 5), rr = r & 15, cc = c & 31, ob = rr * 64 + cc * 2; return st * 1024 + (ob ^ (((ob >> 9) & 1) << 5)); }
__host__ __device__ __forceinline__ void stage_rc(int b, int& R, int& C) { const int st = b / 1024, sb = b % 1024, swz = sb ^ (((sb >> 9) & 1) << 5); R = (st >> 1) * 16 + swz / 64; C = (st & 1) * 32 + (swz % 64) / 2; }
__host__ __device__ __forceinline__ int perm32(int rho) { const int n = rho >> 4, i = rho & 15; return 8 * (i >> 2) + 4 * n + (i & 3); }

struct Unit { int pm, pn; };
struct Gemm { const bf16_t* A; const bf16_t* Bt; int M, N, K; };

struct StaticOrder {
    int nM, nN, nwg, G, c, wgm;
    __host__ __device__ void init(int M, int N, int G_, int c_, int wgm_ = WGM) { nM = M / BM; nN = N / BM; nwg = nM * nN; G = G_; c = c_; wgm = wgm_; }
    __host__ __device__ bool next(int i, Unit& u) const {
        const long L = (long)i * G + c; if (L >= nwg) return false;
        int wgid = (int)L; { const int q = nwg / NXCD, r = nwg % NXCD, xcd = wgid % NXCD, off = wgid / NXCD; wgid = (xcd < r ? xcd * (q + 1) : r * (q + 1) + (xcd - r) * q) + off; }
        const int nig = wgm * nN, gid = wgid / nig, fm = gid * wgm, gsz = (nM - fm) < wgm ? (nM - fm) : wgm;
        u.pm = fm + ((wgid % nig) % gsz); u.pn = (wgid % nig) / gsz; return true;
    }
    __device__ __forceinline__ void a_ready(const Unit&) const {}
    __device__ __forceinline__ void done(const Unit&) const {}
};

__device__ __forceinline__ unsigned cvt_pk_bf16(float lo, float hi) { unsigned r; asm volatile("v_cvt_pk_bf16_f32 %0, %1, %2" : "=v"(r) : "v"(lo), "v"(hi)); return r; }
typedef float f32x2 __attribute__((ext_vector_type(2)));

__device__ __forceinline__ unsigned pk_bf16(float lo, float hi) {
    typedef __bf16 bf2_t __attribute__((ext_vector_type(2))); const f32x2 v = {lo, hi}; return __builtin_bit_cast(unsigned, __builtin_convertvector(v, bf2_t)); }
__device__ __forceinline__ float fsigmoid(float x) { return __builtin_amdgcn_rcpf(1.0f + __builtin_amdgcn_exp2f(-1.4426950408889634f * x)); }
__device__ __forceinline__ float fsilu(float x) { return x * fsigmoid(x); }

template <bool RS> struct EpiSwiglu {
    static constexpr bool PERM = true, AFTER_DRAIN = false;
    bf16_t* O; int ldc; const float* stat;
    __device__ __forceinline__ void operator()(const f32x4 (&acc)[2][2][4][2], const Unit& u, int wr, int wc, int fr, int fq) const {
        const int row0 = u.pm * BM + wr * 64 + fr, col0 = u.pn * HALF + wc * 32 + 8 * fq;
#pragma unroll
        for (int ai = 0; ai < 2; ++ai)
#pragma unroll
            for (int m = 0; m < 4; ++m) { const int row = row0 + ai * HALF + m * 16; bf16_t* rowp = O + (size_t)row * ldc + col0;
                f32x4 g0 = acc[ai][0][m][0], g1 = acc[ai][0][m][1], u0 = acc[ai][1][m][0], u1 = acc[ai][1][m][1];
                if (RS) { const float rs = 1.0f / sqrtf(stat[row] * (1.0f / 4096.0f) + 1e-6f); g0 *= rs; g1 *= rs; u0 *= rs; u1 *= rs; }
                u32x4 w; w.x = pk_bf16(fsilu(g0[0]) * u0[0], fsilu(g0[1]) * u0[1]); w.y = pk_bf16(fsilu(g0[2]) * u0[2], fsilu(g0[3]) * u0[3]);
                w.z = pk_bf16(fsilu(g1[0]) * u1[0], fsilu(g1[1]) * u1[1]); w.w = pk_bf16(fsilu(g1[2]) * u1[2], fsilu(g1[3]) * u1[3]);
                *(u32x4*)rowp = w; }
    }
};
template <bool COPY, size_t XBOFF, size_t STOFF, size_t GOFF> struct EpiResid {
    static constexpr bool PERM = false, AFTER_DRAIN = false;
    const float* base; float* out; int ldc; float scale; unsigned char* ws;
    __device__ __forceinline__ void operator()(const f32x4 (&acc)[2][2][4][2], const Unit& u, int wr, int wc, int fr, int fq) const {
        const int row0 = u.pm * BM + wr * 64 + fr, col0 = u.pn * BM + wc * 32 + 4 * fq;
        bf16_t* XB = (bf16_t*)(ws + XBOFF); float* stat = (float*)(ws + STOFF); const float* gain = (const float*)(ws + GOFF);
        typedef unsigned u32x2_ __attribute__((ext_vector_type(2)));
        f32x4 pre[2][2][2][2]; float ssq[8];
#define ER_LOAD(q, buf) do { _Pragma("unroll") for (int mm = 0; mm < 2; ++mm) { const size_t off_ = (size_t)(row0 + ((q) >> 1) * HALF + (2 * ((q) & 1) + mm) * 16) * ldc + col0; \
            _Pragma("unroll") for (int bj = 0; bj < 2; ++bj) _Pragma("unroll") for (int n = 0; n < 2; ++n) pre[buf][mm][bj][n] = *(const f32x4*)(base + off_ + bj * HALF + n * 16); } } while (0)
        ER_LOAD(0, 0);
#pragma unroll
        for (int q = 0; q < 4; ++q) {
            if (q == 0) ER_LOAD(1, 1); else if (q == 1) ER_LOAD(2, 0); else if (q == 2) ER_LOAD(3, 1);
#pragma unroll
            for (int mm = 0; mm < 2; ++mm) { const int ai = q >> 1, m = 2 * (q & 1) + mm; const size_t off = (size_t)(row0 + ai * HALF + m * 16) * ldc + col0; float ss = 0.f;
#pragma unroll
                for (int bj = 0; bj < 2; ++bj)
#pragma unroll
                    for (int n = 0; n < 2; ++n) {
                        const f32x4 o = pre[q & 1][mm][bj][n] + acc[ai][bj][m][n] * scale;
                        *(f32x4*)(out + off + bj * HALF + n * 16) = o;
                        if (COPY) { const f32x4 gn = *(const f32x4*)(gain + col0 + bj * HALF + n * 16); u32x2_ w; w.x = pk_bf16(o[0] * gn[0], o[1] * gn[1]); w.y = pk_bf16(o[2] * gn[2], o[3] * gn[3]); *(u32x2_*)(XB + off + bj * HALF + n * 16) = w; ss += (o[0] * o[0] + o[1] * o[1]) + (o[2] * o[2] + o[3] * o[3]); } }
                if (COPY) { ss += __shfl_xor(ss, 16); ss += __shfl_xor(ss, 32); ssq[2 * q + mm] = ss; } }
        }
#undef ER_LOAD
        if (COPY) { if (fq == 0) {
#pragma unroll
            for (int i = 0; i < 8; ++i) atomicAdd(stat + row0 + (i >> 2) * HALF + (i & 3) * 16, ssq[i]); } }
    }
};
struct EpiPlain {
    static constexpr bool PERM = true, AFTER_DRAIN = false;
    bf16_t* O; int ldc;
    __device__ __forceinline__ void operator()(const f32x4 (&acc)[2][2][4][2], const Unit& u, int wr, int wc, int fr, int fq) const {
        const int row0 = u.pm * BM + wr * 64 + fr, col0 = u.pn * BM + wc * 32 + 8 * fq;
#pragma unroll
        for (int ai = 0; ai < 2; ++ai)
#pragma unroll
            for (int m = 0; m < 4; ++m) { bf16_t* rowp = O + (size_t)(row0 + ai * HALF + m * 16) * ldc + col0;
#pragma unroll
                for (int bj = 0; bj < 2; ++bj) { const f32x4 v0 = acc[ai][bj][m][0], v1 = acc[ai][bj][m][1];
                    u32x4 w; w.x = pk_bf16(v0[0], v0[1]); w.y = pk_bf16(v0[2], v0[3]); w.z = pk_bf16(v1[0], v1[1]); w.w = pk_bf16(v1[2], v1[3]);
                    *(u32x4*)(rowp + bj * HALF) = w; } }
    }
};
struct EpiWin {
    static constexpr bool PERM = true, AFTER_DRAIN = false;
    bf16_t *HQ, *HV, *G, *CQ, *CKV, *KR; float* LOGF; const float* lb; const float* stat;
    __device__ __forceinline__ void operator()(const f32x4 (&acc)[2][2][4][2], const Unit& u, int wr, int wc, int fr, int fq) const {
        const int pn = u.pn;
        int mode, ld, cbase, espace; bf16_t* dst = nullptr;
        if (pn < 8)       { mode = 1; dst = HQ;  ld = 2048; cbase = pn * 256;        espace = 1; }
        else if (pn < 16) { mode = 2; dst = nullptr; ld = 2048; cbase = (pn - 8) * 256;  espace = 1; }
        else if (pn < 24) { mode = 0; dst = HV;  ld = 2048; cbase = (pn - 16) * 256; espace = 1; }
        else if (pn < 32) { mode = 1; dst = G;   ld = 2048; cbase = (pn - 24) * 256; espace = 0; }
        else if (pn < 36) { mode = 0; dst = CQ;  ld = 1024; cbase = (pn - 32) * 256; espace = 0; }
        else if (pn < 38) { mode = 0; dst = CKV; ld = 512;  cbase = (pn - 36) * 256; espace = 0; }
        else              { mode = 0; dst = KR;  ld = 64;   cbase = 0;               espace = 0; }
#pragma unroll
        for (int ai = 0; ai < 2; ++ai)
#pragma unroll
            for (int m = 0; m < 4; ++m) {
                const int r = u.pm * BM + ai * HALF + wr * 64 + m * 16 + fr;
                if (u.pm * BM + ai * HALF + wr * 64 + m * 16 >= 16400) continue;
                const int drow = espace ? (r < 16384 ? r + 64 : r - 16384 + 48) : r;
                const float rs = 1.0f / sqrtf(stat[r] * (1.0f / 4096.0f) + 1e-6f);
#pragma unroll
                for (int bj = 0; bj < 2; ++bj) {
                    const int c = bj * HALF + wc * 32 + 8 * fq;
                    if (pn == 38 && c >= 64) continue;
                    const f32x4 v0 = acc[ai][bj][m][0] * rs, v1 = acc[ai][bj][m][1] * rs;
                    if (mode == 2) {
                        const f32x4 l0 = *(const f32x4*)(lb + cbase + c), l1 = *(const f32x4*)(lb + cbase + c + 4); f32x4 o0, o1;
#pragma unroll
                        for (int j = 0; j < 4; ++j) { o0[j] = __logf(l0[j] + (1.0f - l0[j]) * fsigmoid(v0[j])); o1[j] = __logf(l1[j] + (1.0f - l1[j]) * fsigmoid(v1[j])); }
                        float* p = LOGF + (size_t)drow * ld + cbase + c; *(f32x4*)p = o0; *(f32x4*)(p + 4) = o1;
                    } else {
                        u32x4 w;
                        if (mode == 1) { w.x = pk_bf16(fsilu(v0[0]), fsilu(v0[1])); w.y = pk_bf16(fsilu(v0[2]), fsilu(v0[3])); w.z = pk_bf16(fsilu(v1[0]), fsilu(v1[1])); w.w = pk_bf16(fsilu(v1[2]), fsilu(v1[3])); }
                        else { w.x = pk_bf16(v0[0], v0[1]); w.y = pk_bf16(v0[2], v0[3]); w.z = pk_bf16(v1[0], v1[1]); w.w = pk_bf16(v1[2], v1[3]); }
                        *(u32x4*)(dst + (size_t)drow * ld + cbase + c) = w;
                    }
                }
            }
    }
};
template <class Epi, class Sched, bool ALIGN_EPI = false, bool SP2 = false>
__device__ __forceinline__ void gemm_phase(PG8_LAS unsigned char* lds, const Gemm g, const Sched& S, const Epi& E) {
    const int tid = threadIdx.x, wid = __builtin_amdgcn_readfirstlane(tid >> 6), lane = tid & 63, wr = wid >> 2, wc = wid & 3, fr = lane & 15, fq = lane >> 4;
    const int K = g.K, nt = K / BK;
    unsigned voffA[2], voffB[2];
#pragma unroll
    for (int i = 0; i < 2; ++i) { int R, C; stage_rc(tid * 16 + i * 8192, R, C); const int Rb = Epi::PERM ? ((R & ~31) + perm32(R & 31)) : R;
        voffA[i] = (unsigned)(R * K + C) * 2u; voffB[i] = (unsigned)(Rb * K + C) * 2u; }
    const size_t kstep = (size_t)(BK * 2);
    const size_t hstep = (size_t)HALF * K * 2;
    const size_t tstep = 2 * hstep;
    const unsigned ldsw = (unsigned)wid * 1024u;
    const int aoff = lds_byte(wr * 64 + fr, fq * 8), boff = lds_byte(wc * 32 + fr, fq * 8);
#define PG8_SA(b, h) (((b) * 2 + (h)) * HTB)
#define PG8_SB(b, h) ((4 + (b) * 2 + (h)) * HTB)
#define PG8_STAGE(bufoff, gbase, voff) do { _Pragma("unroll") for (int _i = 0; _i < 2; ++_i) \
        __builtin_amdgcn_global_load_lds((const unsigned*)((const char*)(gbase) + (voff)[_i]), (PG8_LAS unsigned*)(lds + (bufoff) + ldsw + _i * 8192), 16, 0, 0); } while (0)
#define PG8_LDA(dst, b, h) do { _Pragma("unroll") for (int m = 0; m < 4; ++m) _Pragma("unroll") for (int k = 0; k < 2; ++k) dst[m][k] = *(const PG8_LAS bf16x8*)(lds + PG8_SA(b, h) + aoff + m * 2048 + k * 1024); } while (0)
#define PG8_LDB(dst, b, h) do { _Pragma("unroll") for (int n = 0; n < 2; ++n) _Pragma("unroll") for (int k = 0; k < 2; ++k) dst[n][k] = *(const PG8_LAS bf16x8*)(lds + PG8_SB(b, h) + boff + n * 2048 + k * 1024); } while (0)
#define PG8_MMA(ai, bj, At, Bt) do { __builtin_amdgcn_s_setprio(1); _Pragma("unroll") for (int m = 0; m < 4; ++m) _Pragma("unroll") for (int n = 0; n < 2; ++n) _Pragma("unroll") for (int k = 0; k < 2; ++k) \
        acc[ai][bj][m][n] = __builtin_amdgcn_mfma_f32_16x16x32_bf16(Bt[n][k], At[m][k], acc[ai][bj][m][n], 0, 0, 0); __builtin_amdgcn_s_setprio(0); } while (0)
#define PG8_WAIT_V(n) asm volatile("s_waitcnt vmcnt(" #n ")" ::: "memory")
#define PG8_WAIT_L(n) asm volatile("s_waitcnt lgkmcnt(" #n ")" ::: "memory")
#define PG8_BAR __builtin_amdgcn_s_barrier()
#define PG8_SCHED __builtin_amdgcn_sched_barrier(0)
    Unit cur, nxt; int ui = 0;
    if (!S.next(0, cur)) return;
    f32x4 acc[2][2][4][2];
#pragma unroll
    for (int a = 0; a < 2; ++a)
#pragma unroll
        for (int b = 0; b < 2; ++b)
#pragma unroll
            for (int m = 0; m < 4; ++m)
#pragma unroll
                for (int n = 0; n < 2; ++n) acc[a][b][m][n] = (f32x4){0.f, 0.f, 0.f, 0.f};
    bf16x8 At[4][2], B0[2][2], B1[2][2];
    const char* cA = (const char*)g.A + (size_t)cur.pm * tstep; const char* cB = (const char*)g.Bt + (size_t)cur.pn * tstep;
    S.a_ready(cur);
    if constexpr (SP2) {
        PG8_STAGE(PG8_SB(0, 0), cB, voffB); PG8_STAGE(PG8_SB(0, 1), cB + hstep, voffB); PG8_STAGE(PG8_SA(0, 0), cA, voffA); PG8_STAGE(PG8_SA(0, 1), cA + hstep, voffA);
        if (wr == 1) PG8_BAR;
        PG8_WAIT_V(2); PG8_BAR;
        PG8_STAGE(PG8_SB(1, 0), cB + kstep, voffB); PG8_STAGE(PG8_SA(1, 0), cA + kstep, voffA); PG8_STAGE(PG8_SB(1, 1), cB + hstep + kstep, voffB);
        PG8_WAIT_V(6); PG8_BAR;
    } else {
        PG8_STAGE(PG8_SB(0, 0), cB, voffB); PG8_STAGE(PG8_SA(0, 0), cA, voffA); PG8_STAGE(PG8_SB(0, 1), cB + hstep, voffB); PG8_STAGE(PG8_SA(0, 1), cA + hstep, voffA);
        if (wr == 1) PG8_BAR;
        PG8_WAIT_V(4); PG8_BAR;
        PG8_STAGE(PG8_SB(1, 0), cB + kstep, voffB); PG8_STAGE(PG8_SA(1, 0), cA + kstep, voffA); PG8_STAGE(PG8_SB(1, 1), cB + hstep + kstep, voffB);
        PG8_WAIT_V(6); PG8_BAR;
    }
    for (;;) {
        const bool has_next = S.next(ui + 1, nxt);
        const char* nA = has_next ? (const char*)g.A + (size_t)nxt.pm * tstep : cA; const char* nB = has_next ? (const char*)g.Bt + (size_t)nxt.pn * tstep : cB;
        for (int t = 0; t < nt; t += 2) {
            const bool last = (t == nt - 2);
            const char* a1 = cA + (size_t)(t + 1) * kstep;
            const char* a2 = last ? nA : cA + (size_t)(t + 2) * kstep; const char* b2 = last ? nB : cB + (size_t)(t + 2) * kstep;
            const char* a3 = a2 + kstep; const char* b3 = b2 + kstep;
            if (last && has_next) S.a_ready(nxt);
            if constexpr (SP2) {
            PG8_LDB(B0, 0, 0); PG8_LDB(B1, 0, 1); PG8_SCHED; PG8_LDA(At, 0, 0); PG8_STAGE(PG8_SA(1, 1), a1 + hstep, voffA);
            PG8_WAIT_V(8); PG8_WAIT_L(0); PG8_BAR; PG8_MMA(0, 0, At, B0); PG8_MMA(0, 1, At, B1); PG8_BAR; PG8_SCHED;
            PG8_LDA(At, 0, 1); PG8_STAGE(PG8_SB(0, 0), b2, voffB); PG8_STAGE(PG8_SB(0, 1), b2 + hstep, voffB); PG8_STAGE(PG8_SA(0, 0), a2, voffA);
            PG8_WAIT_V(8); PG8_WAIT_L(0); PG8_BAR; PG8_MMA(1, 0, At, B0); PG8_MMA(1, 1, At, B1); PG8_BAR; PG8_SCHED;
            PG8_LDB(B0, 1, 0); PG8_LDB(B1, 1, 1); PG8_SCHED; PG8_LDA(At, 1, 0); PG8_STAGE(PG8_SA(0, 1), a2 + hstep, voffA);
            PG8_WAIT_V(8); PG8_WAIT_L(0); PG8_BAR; PG8_MMA(0, 0, At, B0); PG8_MMA(0, 1, At, B1); PG8_BAR; PG8_SCHED;
            PG8_LDA(At, 1, 1); PG8_STAGE(PG8_SB(1, 0), b3, voffB); PG8_STAGE(PG8_SB(1, 1), b3 + hstep, voffB); PG8_STAGE(PG8_SA(1, 0), a3, voffA);
            PG8_WAIT_V(8); PG8_WAIT_L(0); PG8_BAR; PG8_MMA(1, 0, At, B0); PG8_MMA(1, 1, At, B1); PG8_BAR; PG8_SCHED;
            } else {
            PG8_LDB(B0, 0, 0); PG8_SCHED; PG8_LDA(At, 0, 0); PG8_STAGE(PG8_SA(1, 1), a1 + hstep, voffA);
            PG8_WAIT_L(8); PG8_BAR; PG8_WAIT_L(0); PG8_MMA(0, 0, At, B0); PG8_BAR; PG8_SCHED;
            PG8_LDB(B1, 0, 1); PG8_STAGE(PG8_SB(0, 0), b2, voffB);
            PG8_BAR; PG8_WAIT_L(0); PG8_MMA(0, 1, At, B1); PG8_BAR;
            PG8_LDA(At, 0, 1); PG8_STAGE(PG8_SA(0, 0), a2, voffA);
            PG8_BAR; PG8_WAIT_L(0); PG8_MMA(1, 0, At, B0); PG8_BAR; PG8_SCHED;
            PG8_STAGE(PG8_SB(0, 1), b2 + hstep, voffB);
            PG8_WAIT_V(6); PG8_BAR; PG8_MMA(1, 1, At, B1); PG8_BAR;
            PG8_LDB(B0, 1, 0); PG8_SCHED; PG8_LDA(At, 1, 0); PG8_STAGE(PG8_SA(0, 1), a2 + hstep, voffA);
            PG8_WAIT_L(8); PG8_BAR; PG8_WAIT_L(0); PG8_MMA(0, 0, At, B0); PG8_BAR; PG8_SCHED;
            PG8_LDB(B1, 1, 1); PG8_STAGE(PG8_SB(1, 0), b3, voffB);
            PG8_BAR; PG8_WAIT_L(0); PG8_MMA(0, 1, At, B1); PG8_BAR;
            PG8_LDA(At, 1, 1); PG8_STAGE(PG8_SA(1, 0), a3, voffA);
            PG8_BAR; PG8_WAIT_L(0); PG8_MMA(1, 0, At, B0); PG8_BAR; PG8_SCHED;
            PG8_STAGE(PG8_SB(1, 1), b3 + hstep, voffB);
            PG8_WAIT_V(6); PG8_BAR; PG8_MMA(1, 1, At, B1); PG8_BAR;
            }
        }
        if constexpr (ALIGN_EPI) { if (wr == 0) PG8_BAR; }
        if constexpr (!Epi::AFTER_DRAIN) { E(acc, cur, wr, wc, fr, fq); S.done(cur); }
        if (!has_next) break;
#pragma unroll
        for (int a = 0; a < 2; ++a)
#pragma unroll
            for (int b = 0; b < 2; ++b)
#pragma unroll
                for (int m = 0; m < 4; ++m)
#pragma unroll
                    for (int n = 0; n < 2; ++n) acc[a][b][m][n] = (f32x4){0.f, 0.f, 0.f, 0.f};
        cur = nxt; cA = nA; cB = nB; ++ui;
        if constexpr (ALIGN_EPI) { if (wr == 1) PG8_BAR; }
    }
    PG8_WAIT_V(0);
    if constexpr (!ALIGN_EPI) { if (wr == 0) PG8_BAR; }
    PG8_BAR;
    if constexpr (Epi::AFTER_DRAIN) { E.fused(acc, cur, wr, wc, fr, fq, lds, wid, lane); S.done(cur); }
#undef PG8_SA
#undef PG8_SB
#undef PG8_STAGE
#undef PG8_LDA
#undef PG8_LDB
#undef PG8_MMA
#undef PG8_WAIT_V
#undef PG8_WAIT_L
#undef PG8_BAR
#undef PG8_SCHED
}
}

constexpr int D = 4096, DFF = 11008, SEQ = 16384, NMETA = 16, LTOT = 16400, MP = 16640;
constexpr int NH = 16, HD = 128, HGW = 2048;
constexpr int QL = 1024, KVL = 512, RD = 64, QKD = 192;
constexpr int INC = 9792, INCP = 9984;
constexpr int ER = 16448;
constexpr int NKT = 257;
constexpr int NCH = 256;
constexpr float EPS = 1e-6f;
constexpr float QSCALE = 0.07216878364870322f * 1.4426950408889634f;
constexpr int NWAVES = 8;

constexpr size_t MiB = 1u << 20;
constexpr size_t al(size_t x) { return (x + MiB - 1) / MiB * MiB; }
constexpr size_t WS_CTL = 0, CTL_ZERO_BYTES = 1 * MiB;
constexpr size_t WS_LB = 1 * MiB;
constexpr size_t WS_G1 = WS_LB + 16384, WS_G2 = WS_LB + 32768;
constexpr size_t WS_COS = WS_LB + 65536, WS_SIN = WS_COS + al((size_t)LTOT * 32 * 4);
constexpr size_t WS_W1GU = WS_SIN + al((size_t)LTOT * 32 * 4);
constexpr size_t WS_W1D = WS_W1GU + al((size_t)2 * DFF * D * 2);
constexpr size_t WS_W2GU = WS_W1D + al((size_t)D * DFF * 2);
constexpr size_t WS_W2D = WS_W2GU + al((size_t)2 * DFF * D * 2);
constexpr size_t WS_WIN = WS_W2D + al((size_t)D * DFF * 2);
constexpr size_t WS_WUQ = WS_WIN + al((size_t)INCP * D * 2);
constexpr size_t WS_WUKV = WS_WUQ + al((size_t)3072 * QL * 2);
constexpr size_t WS_WOUT = WS_WUKV + al((size_t)4096 * KVL * 2);
constexpr size_t WS_HM = WS_WOUT + al((size_t)D * D * 2);
constexpr size_t WS_ARENA = WS_HM + al((size_t)256 * D * 4);
constexpr size_t AR_ACT = WS_ARENA;
constexpr size_t AR_XN = AR_ACT + al((size_t)MP * DFF * 2);
constexpr size_t AR_EXTRA = AR_XN + al((size_t)MP * D * 2);
constexpr size_t AR_HQ = AR_ACT;
constexpr size_t AR_LOGF = AR_HQ + al((size_t)ER * HGW * 2);
constexpr size_t AR_HV = AR_LOGF + al((size_t)ER * HGW * 4);
constexpr size_t AR_G = AR_HV + al((size_t)ER * HGW * 2);
constexpr size_t AR_G_END = AR_G + al((size_t)MP * HGW * 2);
static_assert(AR_G_END <= AR_XN, "P4 outputs must not touch XN");
constexpr size_t AR_MIXED = AR_XN;
constexpr size_t AR_CQ = AR_EXTRA;
constexpr size_t AR_CKV = AR_CQ + al((size_t)MP * QL * 2);
constexpr size_t AR_KR = AR_CKV + al((size_t)MP * KVL * 2);
constexpr size_t AR_CQN = AR_KR + al((size_t)MP * RD * 2);
constexpr size_t AR_CKVN = AR_CQN + al((size_t)MP * QL * 2);
constexpr size_t AR_SU = AR_CKVN + al((size_t)MP * KVL * 2);
constexpr size_t AR_AC = AR_SU + al((size_t)NCH * NH * HD * HD * 2);
constexpr size_t AR_AC_END = AR_AC + al((size_t)NCH * NH * HD * 4);
constexpr size_t AR_QRAW = AR_ACT;
constexpr size_t AR_KVRAW = AR_QRAW + al((size_t)SEQ * 3072 * 2);
constexpr size_t AR_QH = AR_KVRAW + al((size_t)MP * 4096 * 2);
constexpr size_t AR_QH_END = AR_QH + al((size_t)NH * SEQ * QKD * 2);
static_assert(AR_QH_END <= AR_XN, "QH inside the ACT area");
constexpr size_t AR_XN2 = AR_EXTRA;
constexpr size_t AR_KH = AR_SU;
constexpr size_t AR_VT = AR_KH + al((size_t)NH * NKT * 24576);
constexpr size_t AR_VT_END = AR_VT + al((size_t)NH * NKT * 16384);
constexpr size_t WS_END = (AR_VT_END > AR_AC_END ? AR_VT_END : AR_AC_END);
static_assert(AR_XN2 + (size_t)SEQ * D * 2 <= WS_END, "XN2 inside the extra area");

constexpr int CW_BAR = 4096;
constexpr size_t CTL_STAT1 = 65536, CTL_STAT2 = 65536 + 131072;

constexpr int RING_OFF = 0, RING_BYTES = 131072;
constexpr int LDSCTL_OFF = RING_BYTES, MISC_OFF = LDSCTL_OFF + 320;
constexpr int LDS_BYTES = 147456;

#define LAS __attribute__((address_space(3)))
typedef unsigned short bf16;
typedef unsigned v4u __attribute__((ext_vector_type(4)));
typedef unsigned v2u __attribute__((ext_vector_type(2)));
typedef float f32x4 __attribute__((ext_vector_type(4)));
typedef float f32x2 __attribute__((ext_vector_type(2)));
typedef float f32x16 __attribute__((ext_vector_type(16)));
typedef short bf16x8 __attribute__((ext_vector_type(8)));
#define LDS_WAIT() asm volatile("s_waitcnt lgkmcnt(0)" ::: "memory")
#define VM_WAIT() asm volatile("s_waitcnt vmcnt(0)" ::: "memory")
#define MFMA32(a, b, c) __builtin_amdgcn_mfma_f32_32x32x16_bf16((a), (b), (c), 0, 0, 0)
using pg8::pk_bf16;
__device__ __forceinline__ float bf2f(unsigned short b) { return __uint_as_float(((unsigned)b) << 16); }
__device__ __forceinline__ float bflo(unsigned w) { return __uint_as_float(w << 16); }
__device__ __forceinline__ float bfhi(unsigned w) { return __uint_as_float(w & 0xffff0000u); }
__device__ __forceinline__ unsigned short f2bf(float f) { return (unsigned short)(pk_bf16(f, 0.f) & 0xffffu); }
__device__ __forceinline__ float wave_sum(float v) {
#pragma unroll
    for (int o = 1; o < 64; o <<= 1) v += __shfl_xor(v, o);
    return v;
}
__device__ __forceinline__ int crow(int reg, int h) { return (reg & 3) + 8 * (reg >> 2) + 4 * h; }
__device__ __forceinline__ bf16x8 pack8(const f32x16& x, int s) {
    v4u p; p.x = pk_bf16(x[8 * s], x[8 * s + 1]); p.y = pk_bf16(x[8 * s + 2], x[8 * s + 3]); p.z = pk_bf16(x[8 * s + 4], x[8 * s + 5]); p.w = pk_bf16(x[8 * s + 6], x[8 * s + 7]);
    return __builtin_bit_cast(bf16x8, p);
}
#define XB_TMO      128
#define XB_XCNT(j)  (256  + 64 * (j))
#define XB_XSUB(j)  (1280 + 64 * (j))
#define XB_XGEN(j)  (2304 + 64 * (j))
#define XB_TOP      3328
#define XB_TOPGEN   3392
#define XCD_BAR_WORDS 3456
#define XB_SPIN_CAP (1u << 18)

__device__ __forceinline__ unsigned xb_ld(unsigned* p)              { return __hip_atomic_load(p, __ATOMIC_RELAXED, __HIP_MEMORY_SCOPE_AGENT); }
__device__ __forceinline__ unsigned xb_add(unsigned* p, unsigned v) { return __hip_atomic_fetch_add(p, v, __ATOMIC_RELAXED, __HIP_MEMORY_SCOPE_AGENT); }
__device__ __forceinline__ unsigned xb_xcc_id() { return (unsigned)__builtin_amdgcn_s_getreg((3 << 11) | 20) & 0xFu; }
#define XB_SPIN(cond, bar) do { unsigned _sp = 0; while (cond) { __builtin_amdgcn_s_sleep(1); \
    if ((++_sp & 255u) == 0u) { if (xb_ld(&(bar)[XB_TMO])) break; if (_sp > XB_SPIN_CAP) { atomicAdd(&(bar)[XB_TMO], 1u); break; } } } } while (0)

struct XcdBarrier {
    unsigned* bar; unsigned x;
    volatile LAS unsigned* st;
};

__device__ __forceinline__ XcdBarrier xcd_barrier_post(unsigned* bar, volatile LAS unsigned* st) {
    XcdBarrier b; b.bar = bar; b.x = xb_xcc_id(); b.st = st;
    if (threadIdx.x == 0) (void)xb_add(&bar[XB_XCNT(b.x)], 1u);
    return b;
}
__device__ __forceinline__ void xcd_barrier_complete(unsigned* bar, unsigned x, unsigned& nloc, unsigned& nx) {
    const unsigned G = gridDim.x * gridDim.y * gridDim.z;
    unsigned sum, cnt, mine, sp = 0u;
    for (;;) {
        sum = 0u; cnt = 0u; mine = 0u;
#pragma unroll
        for (unsigned j = 0; j < 16; ++j) { const unsigned c = xb_ld(&bar[XB_XCNT(j)]); sum += c; cnt += (c > 0u) ? 1u : 0u; mine = (j == x) ? c : mine; }
        if (sum == G) break;
        __builtin_amdgcn_s_sleep(1);
        if ((++sp & 255u) == 0u) { if (xb_ld(&bar[XB_TMO])) break; if (sp > XB_SPIN_CAP) { atomicAdd(&bar[XB_TMO], 1u); break; } }
    }
    nloc = mine > 0u ? mine : 1u; nx = cnt > 0u ? cnt : 1u;
}

__device__ __forceinline__ void xcd_barrier(const XcdBarrier& b) {
    asm volatile("s_waitcnt vmcnt(0)" ::: "memory");
    __syncthreads();
    if (threadIdx.x == 0) {
        unsigned* bar = b.bar;
        __builtin_amdgcn_s_waitcnt(0);
        unsigned nloc = b.st[0], nx = b.st[1];
        if (nloc == 0u) { xcd_barrier_complete(bar, b.x, nloc, nx); b.st[0] = nloc; b.st[1] = nx; }
        const unsigned old = xb_add(&bar[XB_XSUB(b.x)], 1u);
        const unsigned gen = old / nloc;
        if (old + 1u == (gen + 1u) * nloc) {
            __builtin_amdgcn_fence(__ATOMIC_RELEASE, "agent");
            asm volatile("s_waitcnt vmcnt(0)" ::: "memory");
            const unsigned og = xb_add(&bar[XB_TOP], 1u);
            const unsigned tg = og / nx;
            if (og + 1u == (tg + 1u) * nx) xb_add(&bar[XB_TOPGEN], 1u);
            else XB_SPIN(xb_ld(&bar[XB_TOPGEN]) == tg, bar);
            __builtin_amdgcn_fence(__ATOMIC_ACQUIRE, "agent");
            xb_add(&bar[XB_XGEN(b.x)], 1u);
            asm volatile("s_waitcnt vmcnt(0)" ::: "memory");
        } else {
            XB_SPIN(xb_ld(&bar[XB_XGEN(b.x)]) == gen, bar);
            __builtin_amdgcn_fence(__ATOMIC_ACQUIRE, "agent");
            asm volatile("s_waitcnt vmcnt(0)" ::: "memory");
        }
    }
    __syncthreads();
}

struct Args { const float* in[22]; float* out; unsigned char* ws; int ph_lo, ph_hi; };
struct Frame {
    LAS unsigned char* lds;
    int tid, lane, wave, G, vcu;
    unsigned char* ws; float* out;
};

struct TItem { const float* W; bf16* WT; int K, N, k0, n0, drow0; };
__device__ __forceinline__ void titem_load(const TItem& t, float (&v)[32], int lane) {
    const float* p = t.W + (size_t)(t.k0 + (lane >> 5)) * t.N + t.n0 + (lane & 31);
#pragma unroll
    for (int i = 0; i < 32; ++i) v[i] = __builtin_nontemporal_load(p + (size_t)(2 * i) * t.N);
}
__device__ __forceinline__ void titem_store(const TItem& t, const float (&v)[32], LAS float* scr, int lane) {
#pragma unroll
    for (int i = 0; i < 32; ++i) scr[(2 * i + (lane >> 5)) * 33 + (lane & 31)] = v[i];
    LDS_WAIT(); asm volatile("" ::: "memory");
    const int c = lane & 7;
#pragma unroll
    for (int j = 0; j < 4; ++j) { const int n = (lane >> 3) + 8 * j; const LAS float* s = scr + (8 * c) * 33 + n;
        v4u o; o.x = pk_bf16(s[0 * 33], s[1 * 33]); o.y = pk_bf16(s[2 * 33], s[3 * 33]); o.z = pk_bf16(s[4 * 33], s[5 * 33]); o.w = pk_bf16(s[6 * 33], s[7 * 33]);
        *(v4u*)(t.WT + (size_t)(t.drow0 + n) * t.K + t.k0 + 8 * c) = o; }
    LDS_WAIT(); asm volatile("" ::: "memory");
}
__device__ __forceinline__ void rms_row_to_bf16(const float* xrow, const float* w, bf16* orow, int lane) {
    const f32x4* xr = (const f32x4*)xrow + lane; const f32x4* wr = (const f32x4*)w + lane;
    f32x4 v[16]; float s = 0.f;
#pragma unroll
    for (int j = 0; j < 16; ++j) { v[j] = xr[64 * j]; s += (v[j].x * v[j].x + v[j].y * v[j].y) + (v[j].z * v[j].z + v[j].w * v[j].w); }
    const float rstd = 1.0f / sqrtf(wave_sum(s) * (1.0f / D) + EPS);
    v2u* o8 = (v2u*)orow + lane;
#pragma unroll
    for (int j = 0; j < 16; ++j) { const f32x4 g = wr[64 * j]; v2u o; o.x = pk_bf16(v[j].x * rstd * g.x, v[j].y * rstd * g.y); o.y = pk_bf16(v[j].z * rstd * g.z, v[j].w * rstd * g.w); o8[64 * j] = o; }
}
__device__ __forceinline__ void norm_phase(const Frame& F, const float* lo, const float* hi, const float* w, bf16* XN, int nrows, int nzero_to) {
    const int gw = F.vcu * NWAVES + F.wave, NGW = F.G * NWAVES;
    for (int r = gw; r < nrows; r += NGW) rms_row_to_bf16(r < SEQ ? lo + (size_t)r * D : hi + (size_t)(r - SEQ) * D, w, XN + (size_t)r * D, F.lane);
    for (int r = nrows + gw; r < nzero_to; r += NGW) { v4u* o = (v4u*)(XN + (size_t)r * D) + F.lane;
#pragma unroll
        for (int j = 0; j < 8; ++j) o[64 * j] = (v4u){0u, 0u, 0u, 0u}; }
}
__device__ const float ROPE_INVF[32] = {1.000000000e+00f, 7.498942018e-01f, 5.623413324e-01f, 4.216965139e-01f, 3.162277639e-01f, 2.371373922e-01f, 1.778279394e-01f, 1.333521456e-01f, 1.000000015e-01f, 7.498941571e-02f, 5.623412877e-02f, 4.216964915e-02f, 3.162277862e-02f, 2.371373586e-02f, 1.778279431e-02f, 1.333521493e-02f, 9.999999776e-03f, 7.498942316e-03f, 5.623413250e-03f, 4.216964822e-03f, 3.162277862e-03f, 2.371373819e-03f, 1.778279431e-03f, 1.333521446e-03f, 1.000000047e-03f, 7.498941850e-04f, 5.623413017e-04f, 4.216965463e-04f, 3.162277862e-04f, 2.371373848e-04f, 1.778279402e-04f, 1.333521504e-04f};
__device__ __forceinline__ void sincos_d(double a, float& c, float& s) {
    const double TWO_OVER_PI = 0.63661977236758134308, PIO2_HI = 1.57079632673412561417, PIO2_LO = 6.07710050650619224932e-11;
    const double q = __builtin_rint(a * TWO_OVER_PI); const double r = (a - q * PIO2_HI) - q * PIO2_LO; const int qi = (int)q & 3;
    const double r2 = r * r;
    const double sp = r * (1.0 + r2 * (-1.0 / 6 + r2 * (1.0 / 120 + r2 * (-1.0 / 5040 + r2 * (1.0 / 362880 + r2 * (-1.0 / 39916800 + r2 * (1.0 / 6227020800.0)))))));
    const double cp = 1.0 + r2 * (-0.5 + r2 * (1.0 / 24 + r2 * (-1.0 / 720 + r2 * (1.0 / 40320 + r2 * (-1.0 / 3628800 + r2 * (1.0 / 479001600.0 + r2 * (-1.0 / 87178291200.0)))))));
    const double sv = (qi == 0) ? sp : (qi == 1) ? cp : (qi == 2) ? -sp : -cp;
    const double cv = (qi == 0) ? cp : (qi == 1) ? -sp : (qi == 2) ? -cp : sp;
    c = (float)cv; s = (float)sv;
}
constexpr int KB_D = D / 64, KB_F = DFF / 64;
constexpr long I_GU = (long)KB_D * (DFF / 32), I_DN = (long)KB_F * (D / 32);
constexpr long I_IN = (long)KB_D * (INC / 32), I_UQ = (long)(QL / 64) * (3072 / 32), I_UKV = (long)(KVL / 64) * (4096 / 32), I_OUT = (long)KB_D * (D / 32);
constexpr long NITEMS = 4 * I_GU + 2 * I_DN + I_IN + I_UQ + I_UKV + I_OUT;
__device__ __forceinline__ void titem_decode(const Args& A, unsigned char* ws, long r, TItem& t) {
        if (r < 4 * I_GU) {
            const int which = (int)(r / I_GU); const int q = (int)(r % I_GU); const int nb = q % (DFF / 32), kb = q / (DFF / 32), n0 = nb * 32;
            const float* w4 = A.in[4]; const float* w5 = A.in[5]; const float* w18 = A.in[18]; const float* w19 = A.in[19]; t.W = which == 0 ? w4 : which == 1 ? w5 : which == 2 ? w18 : w19;     t.WT = (bf16*)(ws + (which < 2 ? WS_W1GU : WS_W2GU)); t.K = D; t.N = DFF; t.k0 = kb * 64; t.n0 = n0;
            t.drow0 = 256 * (n0 >> 7) + (n0 & 127) + ((which & 1) ? 128 : 0); return; }
        r -= 4 * I_GU;
        if (r < 2 * I_DN) { const int which = (int)(r / I_DN); const int q = (int)(r % I_DN); const int nb = q % (D / 32), kb = q / (D / 32);
            const float* w20 = A.in[20]; const float* w6 = A.in[6]; t.W = which ? w20 : w6; t.WT = (bf16*)(ws + (which ? WS_W2D : WS_W1D)); t.K = DFF; t.N = D; t.k0 = kb * 64; t.n0 = nb * 32; t.drow0 = nb * 32; return; }
        r -= 2 * I_DN;
        if (r < I_IN) { const int q = (int)r; const int nb = q % (INC / 32), kb = q / (INC / 32); t.W = A.in[8]; t.WT = (bf16*)(ws + WS_WIN); t.K = D; t.N = INC; t.k0 = kb * 64; t.n0 = nb * 32; t.drow0 = nb * 32; return; }
        r -= I_IN;
        if (r < I_UQ) { const int q = (int)r; const int nb = q % (3072 / 32), kb = q / (3072 / 32); t.W = A.in[11]; t.WT = (bf16*)(ws + WS_WUQ); t.K = QL; t.N = 3072; t.k0 = kb * 64; t.n0 = nb * 32; t.drow0 = nb * 32; return; }
        r -= I_UQ;
        if (r < I_UKV) { const int q = (int)r; const int nb = q % (4096 / 32), kb = q / (4096 / 32); t.W = A.in[13]; t.WT = (bf16*)(ws + WS_WUKV); t.K = KVL; t.N = 4096; t.k0 = kb * 64; t.n0 = nb * 32; t.drow0 = nb * 32; return; }
        r -= I_UKV;
        { const int q = (int)r; const int nb = q % (D / 32), kb = q / (D / 32); t.W = A.in[16]; t.WT = (bf16*)(ws + WS_WOUT); t.K = D; t.N = D; t.k0 = kb * 64; t.n0 = nb * 32; t.drow0 = nb * 32; }
}
__device__ __forceinline__ void p0_prologue(const Frame& F, const Args& A) {
    unsigned char* ws = F.ws;
    LAS float* scr = (LAS float*)(F.lds + RING_OFF + F.wave * 16384);
    const int gw = F.vcu * NWAVES + F.wave, NGW = F.G * NWAVES;
    if (gw < NITEMS) {
        TItem cur, nxt; float va[32], vb[32];
        titem_decode(A, ws, gw, cur); titem_load(cur, va, F.lane);
        for (long it = gw; it < NITEMS; it += 2 * NGW) {
            const bool h1 = it + NGW < NITEMS; if (h1) { titem_decode(A, ws, it + NGW, nxt); titem_load(nxt, vb, F.lane); }
            titem_store(cur, va, scr, F.lane);
            if (!h1) break;
            const bool h2 = it + 2 * NGW < NITEMS; if (h2) { titem_decode(A, ws, it + 2 * NGW, cur); titem_load(cur, va, F.lane); }
            titem_store(nxt, vb, scr, F.lane);
            if (!h2) break;
        }
    }
    { v4u* z = (v4u*)(ws + WS_WIN + (size_t)INC * D * 2); const size_t n16 = (size_t)(INCP - INC) * D * 2 / 16;
      for (size_t i = (size_t)F.vcu * 512 + F.tid; i < n16; i += (size_t)F.G * 512) z[i] = (v4u){0u, 0u, 0u, 0u}; }
    { float* HM = (float*)(ws + WS_HM); const float* meta = A.in[1];
      for (int i = F.vcu * 512 + F.tid; i < 256 * D; i += F.G * 512) HM[i] = (i < NMETA * D) ? meta[i] : 0.f; }
    norm_phase(F, A.in[0], A.in[1], A.in[3], (bf16*)(ws + AR_XN), LTOT, MP);
    { float* g1 = (float*)(ws + WS_G1); float* g2 = (float*)(ws + WS_G2); for (int i = F.vcu * 512 + F.tid; i < D; i += F.G * 512) { g1[i] = A.in[7][i]; g2[i] = A.in[17][i]; } }
    { float* lb = (float*)(ws + WS_LB); const float* lp = A.in[2];
      for (int i = F.vcu * 512 + F.tid; i < HGW; i += F.G * 512) { const float a = lp[i], b = lp[HGW + i], m = fmaxf(a, b); const float ea = expf(a - m), eb = expf(b - m); lb[i] = ea / (ea + eb); } }
    { float* ct = (float*)(ws + WS_COS); float* st = (float*)(ws + WS_SIN);
      for (int i = F.vcu * 512 + F.tid; i < LTOT * 32; i += F.G * 512) { const int pos = i >> 5, k = i & 31;
          const float invf = ROPE_INVF[k];
          const float ang = (float)pos * invf; float c, s; sincos_d((double)ang, c, s); ct[i] = c; st[i] = s; } }
}
__device__ __forceinline__ void zero_null_rows(const Frame& F) {
    float* LOGF = (float*)(F.ws + AR_LOGF); unsigned* HVw = (unsigned*)(F.ws + AR_HV);
    for (int i = F.vcu * 512 + F.tid; i < 48 * HGW; i += F.G * 512) { LOGF[i] = 0.f; if (i < 48 * HGW / 2) HVw[i] = 0u; }
}
__device__ __forceinline__ void final_norm(const Frame& F, const float* w) {
    const int gw = F.vcu * NWAVES + F.wave, NGW = F.G * NWAVES;
    int lane = F.lane; asm volatile("" : "+v"(lane));
    for (int r = gw; r < SEQ; r += NGW) {
        f32x4* xr = (f32x4*)(F.out + (size_t)r * D) + lane; const f32x4* wr = (const f32x4*)w + lane;
        f32x4 v[16]; float s = 0.f;
#pragma unroll
        for (int j = 0; j < 16; ++j) { v[j] = xr[64 * j]; s += (v[j].x * v[j].x + v[j].y * v[j].y) + (v[j].z * v[j].z + v[j].w * v[j].w); }
        const float rstd = 1.0f / sqrtf(wave_sum(s) * (1.0f / D) + EPS);
#pragma unroll
        for (int j = 0; j < 16; ++j) { const f32x4 g = wr[64 * j]; xr[64 * j] = v[j] * rstd * g; }
    }
}

__device__ __forceinline__ void meta_down_phase(const Frame& F, const bf16* ACT, const bf16* WT, float* HM, float scale, bf16* XB, float* stat, const float* gain) {
    typedef float f32x4_ __attribute__((ext_vector_type(4)));
    LAS float* red = (LAS float*)(F.lds + RING_OFF);
    const int i = F.lane & 15, kq = F.lane >> 4;
    for (int cb = F.vcu; cb < D / 16; cb += F.G) {
        const bf16* ap = ACT + (size_t)(SEQ + i) * DFF + F.wave * 1376 + 8 * kq;
        const bf16* bp = WT + (size_t)(16 * cb + i) * DFF + F.wave * 1376 + 8 * kq;
        f32x4_ acc = {0.f, 0.f, 0.f, 0.f};
#pragma unroll 8
        for (int s = 0; s < 43; ++s) { const bf16x8 a = *(const bf16x8*)(ap + 32 * s); const bf16x8 b = *(const bf16x8*)(bp + 32 * s); acc = __builtin_amdgcn_mfma_f32_16x16x32_bf16(a, b, acc, 0, 0, 0); }
#pragma unroll
        for (int j = 0; j < 4; ++j) red[F.wave * 256 + (4 * kq + j) * 16 + i] = acc[j];
        __syncthreads();
        if (F.tid < 256) { float s = 0.f;
#pragma unroll
            for (int w = 0; w < 8; ++w) s += red[w * 256 + F.tid];
            const int row = F.tid >> 4, col = 16 * cb + (F.tid & 15); const float v = HM[(size_t)row * D + col] + scale * s; HM[(size_t)row * D + col] = v;
            XB[(size_t)(SEQ + row) * D + col] = f2bf(v * gain[col]); float q = v * v; q += __shfl_xor(q, 1); q += __shfl_xor(q, 2); q += __shfl_xor(q, 4); q += __shfl_xor(q, 8); if ((F.tid & 15) == 0) atomicAdd(stat + SEQ + row, q); }
        __syncthreads();
    }
}
template <int N>
__device__ __forceinline__ void lat_norm(const Frame& F, const bf16* src, const float* w, bf16* dst, int nvalid, int ntotal) {
    constexpr int PER = N / 64;
    const int gw = F.vcu * NWAVES + F.wave, NGW = F.G * NWAVES;
    for (int r = gw; r < ntotal; r += NGW) {
        unsigned xw[PER / 2]; float x[PER]; float s = 0.f;
        if (r < nvalid) {
#pragma unroll
            for (int j = 0; j < PER / 8; ++j) { const v4u t = *((const v4u*)(src + (size_t)r * N + F.lane * PER) + j); xw[4 * j] = t.x; xw[4 * j + 1] = t.y; xw[4 * j + 2] = t.z; xw[4 * j + 3] = t.w; }
#pragma unroll
            for (int j = 0; j < PER / 2; ++j) { x[2 * j] = bflo(xw[j]); x[2 * j + 1] = bfhi(xw[j]); s += x[2 * j] * x[2 * j] + x[2 * j + 1] * x[2 * j + 1]; }
            const float rstd = 1.0f / sqrtf(wave_sum(s) * (1.0f / N) + EPS);
#pragma unroll
            for (int j = 0; j < PER / 8; ++j) { const f32x4 g0 = *(const f32x4*)(w + F.lane * PER + 8 * j), g1 = *(const f32x4*)(w + F.lane * PER + 8 * j + 4);
                v4u o; o.x = pk_bf16(x[8 * j] * rstd * g0.x, x[8 * j + 1] * rstd * g0.y); o.y = pk_bf16(x[8 * j + 2] * rstd * g0.z, x[8 * j + 3] * rstd * g0.w);
                o.z = pk_bf16(x[8 * j + 4] * rstd * g1.x, x[8 * j + 5] * rstd * g1.y); o.w = pk_bf16(x[8 * j + 6] * rstd * g1.z, x[8 * j + 7] * rstd * g1.w);
                *((v4u*)(dst + (size_t)r * N + F.lane * PER) + j) = o; }
        } else {
#pragma unroll
            for (int j = 0; j < PER / 8; ++j) *((v4u*)(dst + (size_t)r * N + F.lane * PER) + j) = (v4u){0u, 0u, 0u, 0u};
        }
    }
}

__device__ __forceinline__ void hgrn_cumsum8(const f32x2 (&g)[8], f32x2 (&c)[8]) { c[0] = g[0];
#pragma unroll
    for (int i = 1; i < 8; ++i) c[i] = c[i - 1] + g[i]; }

__device__ __forceinline__ void hgrn_pass_a(const Frame& F) {
    const float* LOGF = (const float*)(F.ws + AR_LOGF); const unsigned* HVw = (const unsigned*)(F.ws + AR_HV);
    bf16* SU = (bf16*)(F.ws + AR_SU); float* AC = (float*)(F.ws + AR_AC);
    LAS unsigned char* KDT = F.lds + RING_OFF; LAS unsigned char* VTT = F.lds + RING_OFF + 16384; LAS float* SEGT = (LAS float*)(F.lds + RING_OFF + 32768);
    const int c2 = F.lane, seg = F.wave, hh = F.lane >> 5, l31 = F.lane & 31;
    f32x2 gn[8]; unsigned vn[8];
#define HA_FETCH(it_) do { const int cc_ = (it_) >> 4, h_ = (it_) & 15; _Pragma("unroll") for (int i = 0; i < 8; ++i) { const size_t row = (size_t)(64 * cc_ + 8 * seg + i); \
        gn[i] = *(const f32x2*)(LOGF + row * HGW + h_ * HD + 2 * c2); vn[i] = HVw[(row * HGW + h_ * HD + 2 * c2) >> 1]; } } while (0)
    if (F.vcu < NCH * NH) HA_FETCH(F.vcu);
    for (int item = F.vcu; item < NCH * NH; item += F.G) {
        const int cc = item >> 4, h = item & 15;
        f32x2 g[8], c[8]; unsigned vw[8];
#pragma unroll
        for (int i = 0; i < 8; ++i) { g[i] = gn[i]; vw[i] = vn[i]; }
        if (item + F.G < NCH * NH) HA_FETCH(item + F.G);
        hgrn_cumsum8(g, c);
        *(LAS f32x2*)(SEGT + seg * 128 + 2 * c2) = c[7];
        __syncthreads();
        f32x2 off = {0.f, 0.f}, tot = {0.f, 0.f};
#pragma unroll
        for (int s = 0; s < 8; ++s) { const f32x2 t = *(const LAS f32x2*)(SEGT + s * 128 + 2 * c2); tot += t; if (s < seg) off += t; }
        float k0[8], k1[8];
#pragma unroll
        for (int i = 0; i < 8; ++i) { const f32x2 b = off + c[i];
            k0[i] = (1.0f - __expf(g[i].x)) * __expf(tot.x - b.x); k1[i] = (1.0f - __expf(g[i].y)) * __expf(tot.y - b.y); }
        const int sw = ((seg ^ (c2 & 7)) << 4);
        { v4u p; p.x = pk_bf16(k0[0], k0[1]); p.y = pk_bf16(k0[2], k0[3]); p.z = pk_bf16(k0[4], k0[5]); p.w = pk_bf16(k0[6], k0[7]); *(LAS v4u*)(KDT + (2 * c2) * 128 + sw) = p;
          v4u q; q.x = pk_bf16(k1[0], k1[1]); q.y = pk_bf16(k1[2], k1[3]); q.z = pk_bf16(k1[4], k1[5]); q.w = pk_bf16(k1[6], k1[7]); *(LAS v4u*)(KDT + (2 * c2 + 1) * 128 + sw) = q; }
        { v4u p, q;
          p.x = (vw[0] & 0xffffu) | (vw[1] << 16); p.y = (vw[2] & 0xffffu) | (vw[3] << 16); p.z = (vw[4] & 0xffffu) | (vw[5] << 16); p.w = (vw[6] & 0xffffu) | (vw[7] << 16);
          q.x = (vw[0] >> 16) | (vw[1] & 0xffff0000u); q.y = (vw[2] >> 16) | (vw[3] & 0xffff0000u); q.z = (vw[4] >> 16) | (vw[5] & 0xffff0000u); q.w = (vw[6] >> 16) | (vw[7] & 0xffff0000u);
          *(LAS v4u*)(VTT + (2 * c2) * 128 + sw) = p; *(LAS v4u*)(VTT + (2 * c2 + 1) * 128 + sw) = q; }
        if (seg == 7) { f32x2 a; a.x = __expf(tot.x); a.y = __expf(tot.y); *(f32x2*)(AC + (size_t)item * HD + 2 * c2) = a; }
        __syncthreads();
        const int dvb = F.wave & 3, dkb0 = 2 * (F.wave >> 2);
        bf16x8 vf[4];
        { const int dv = dvb * 32 + l31;
#pragma unroll
          for (int ks = 0; ks < 4; ++ks) vf[ks] = *(const LAS bf16x8*)(VTT + dv * 128 + (((2 * ks + hh) ^ ((dv >> 1) & 7)) << 4)); }
#pragma unroll
        for (int q = 0; q < 2; ++q) {
            const int dk = (dkb0 + q) * 32 + l31; f32x16 acc;
#pragma unroll
            for (int i = 0; i < 16; ++i) acc[i] = 0.f;
#pragma unroll
            for (int ks = 0; ks < 4; ++ks) { const bf16x8 kf = *(const LAS bf16x8*)(KDT + dk * 128 + (((2 * ks + hh) ^ ((dk >> 1) & 7)) << 4)); acc = MFMA32(kf, vf[ks], acc); }
            bf16* dst = SU + (size_t)item * (HD * HD) + (size_t)(dvb * 32 + l31) * HD + (dkb0 + q) * 32 + 4 * hh;
#pragma unroll
            for (int g4 = 0; g4 < 4; ++g4) { v2u o; o.x = pk_bf16(acc[4 * g4], acc[4 * g4 + 1]); o.y = pk_bf16(acc[4 * g4 + 2], acc[4 * g4 + 3]); *(v2u*)(dst + 8 * g4) = o; }
        }
    }
    __syncthreads();
#undef HA_FETCH
}

__device__ __forceinline__ void hgrn_pass_b(const Frame& F) {
    unsigned* SUw = (unsigned*)(F.ws + AR_SU); const float* AC = (const float*)(F.ws + AR_AC);
    constexpr int NB = 16;
    for (int gt = F.vcu * 512 + F.tid; gt < NH * HD * (HD / 2); gt += F.G * 512) {
        const int h = gt >> 13, rem = gt & 8191, dkp = rem & 63;
        unsigned* up = SUw + (size_t)h * (HD * HD / 2) + rem; const float* ap = AC + (size_t)h * HD + 2 * dkp;
        f32x2 S = {0.f, 0.f};
        unsigned ua[NB], ub[NB]; f32x2 aa[NB], ab[NB];
#define HB_LOAD(u_, a_, c0_) do { _Pragma("unroll") for (int j = 0; j < NB; ++j) { u_[j] = up[(size_t)((c0_) + j) * (NH * HD * HD / 2)]; a_[j] = *(const f32x2*)(ap + (size_t)((c0_) + j) * (NH * HD)); } } while (0)
#define HB_STEP(u_, a_, c0_) do { unsigned o_[NB]; _Pragma("unroll") for (int j = 0; j < NB; ++j) { S.x = a_[j].x * S.x + bflo(u_[j]); S.y = a_[j].y * S.y + bfhi(u_[j]); o_[j] = pk_bf16(S.x, S.y); } \
        _Pragma("unroll") for (int j = 0; j < NB; ++j) up[(size_t)((c0_) + j) * (NH * HD * HD / 2)] = o_[j]; } while (0)
        HB_LOAD(ua, aa, 0);
#pragma unroll 1
        for (int c0 = 0; c0 < NCH; c0 += 2 * NB) {
            HB_LOAD(ub, ab, c0 + NB);
            HB_STEP(ua, aa, c0);
            if (c0 + 2 * NB < NCH) HB_LOAD(ua, aa, c0 + 2 * NB);
            HB_STEP(ub, ab, c0 + NB);
        }
#undef HB_LOAD
#undef HB_STEP
    }
}

__device__ __forceinline__ void hgrn_pass_c(const Frame& F, const float* hg_norm) {
    const float* LOGF = (const float*)(F.ws + AR_LOGF); const unsigned* HVw = (const unsigned*)(F.ws + AR_HV); const unsigned* HQw = (const unsigned*)(F.ws + AR_HQ);
    const bf16* SU = (const bf16*)(F.ws + AR_SU); const bf16* G = (const bf16*)(F.ws + AR_G); bf16* MIXED = (bf16*)(F.ws + AR_MIXED);
    LAS unsigned char* QT = F.lds + RING_OFF; LAS unsigned char* QHh = F.lds + RING_OFF + 16384; LAS unsigned char* KT = F.lds + RING_OFF + 32768; LAS unsigned char* VTP = F.lds + RING_OFF + 49152;
    LAS float* SEGT = (LAS float*)(F.lds + RING_OFF + 65536); LAS float* SS = (LAS float*)(F.lds + RING_OFF + 69632);
    const int c2 = F.lane, seg = F.wave, hh = F.lane >> 5, l31 = F.lane & 31;
    f32x2 gn[8]; unsigned vn[8], qn[8];
#define HC_FETCH(it_) do { const int cc_ = ((it_) >> 4) + 1, h_ = (it_) & 15; _Pragma("unroll") for (int i = 0; i < 8; ++i) { const size_t idx = (size_t)(64 * cc_ + 8 * seg + i) * HGW + h_ * HD + 2 * c2; \
        gn[i] = *(const f32x2*)(LOGF + idx); vn[i] = HVw[idx >> 1]; qn[i] = HQw[idx >> 1]; } } while (0)
    if (F.vcu < NCH * NH) HC_FETCH(F.vcu);
    for (int item = F.vcu; item < NCH * NH; item += F.G) {
        const int cc = (item >> 4) + 1, h = item & 15;
        f32x2 g[8], c[8]; unsigned vw[8], qw[8];
#pragma unroll
        for (int i = 0; i < 8; ++i) { g[i] = gn[i]; vw[i] = vn[i]; qw[i] = qn[i]; }
        const int dvb = F.wave & 3, tb = F.wave >> 2;
        const int trow = 32 * tb + l31, dv = dvb * 32 + l31;
        bf16x8 sfr[8]; v2u gtv[4];
        { const bf16* srow = SU + (size_t)((cc - 1) * NH + h) * (HD * HD) + (size_t)dv * HD + 8 * hh;
#pragma unroll
          for (int ks = 0; ks < 8; ++ks) sfr[ks] = *(const bf16x8*)(srow + 16 * ks);
#pragma unroll
          for (int g4 = 0; g4 < 4; ++g4) gtv[g4] = *(const v2u*)(G + (size_t)(64 * (cc - 1) + trow) * HGW + h * HD + dvb * 32 + 8 * g4 + 4 * hh); }
        hgrn_cumsum8(g, c);
        *(LAS f32x2*)(SEGT + seg * 128 + 2 * c2) = c[7];
        __syncthreads();
        f32x2 off = {0.f, 0.f}, bmid = {0.f, 0.f};
#pragma unroll
        for (int s = 0; s < 4; ++s) { const f32x2 t = *(const LAS f32x2*)(SEGT + s * 128 + 2 * c2); bmid += t; if (s < seg) off += t; }
#pragma unroll
        for (int s = 4; s < 7; ++s) { const f32x2 t = *(const LAS f32x2*)(SEGT + s * 128 + 2 * c2); if (s < seg) off += t; }
#pragma unroll
        for (int i = 0; i < 8; ++i) {
            const int t = 8 * seg + i; const f32x2 b = off + c[i]; const float q0 = bflo(qw[i]), q1 = bfhi(qw[i]);
            const unsigned qh = pk_bf16(q0 * __expf(b.x), q1 * __expf(b.y));
            const unsigned qt = pk_bf16(q0 * __expf(b.x - bmid.x), q1 * __expf(b.y - bmid.y));
            const unsigned kt = pk_bf16((1.0f - __expf(g[i].x)) * __expf(bmid.x - b.x), (1.0f - __expf(g[i].y)) * __expf(bmid.y - b.y));
            const int o = t * 256 + ((((c2 >> 2) ^ (t & 15))) << 4) + ((c2 & 3) << 2);
            *(LAS unsigned*)(QHh + o) = qh; *(LAS unsigned*)(QT + o) = qt; *(LAS unsigned*)(KT + o) = kt;
        }
        {
          const int sb = seg >> 2, stp = (seg >> 1) & 1, chunk0 = sb * 4 + stp * 2, bo = (seg & 1) << 3, sz = c2 & 7;
          v2u a0, a1, b0, b1;
          a0.x = (vw[0] & 0xffffu) | (vw[1] << 16); a0.y = (vw[2] & 0xffffu) | (vw[3] << 16); b0.x = (vw[4] & 0xffffu) | (vw[5] << 16); b0.y = (vw[6] & 0xffffu) | (vw[7] << 16);
          a1.x = (vw[0] >> 16) | (vw[1] & 0xffff0000u); a1.y = (vw[2] >> 16) | (vw[3] & 0xffff0000u); b1.x = (vw[4] >> 16) | (vw[5] & 0xffff0000u); b1.y = (vw[6] >> 16) | (vw[7] & 0xffff0000u);
          *(LAS v2u*)(VTP + (2 * c2) * 128 + (((chunk0) ^ sz) << 4) + bo) = a0; *(LAS v2u*)(VTP + (2 * c2) * 128 + (((chunk0 + 1) ^ sz) << 4) + bo) = b0;
          *(LAS v2u*)(VTP + (2 * c2 + 1) * 128 + (((chunk0) ^ sz) << 4) + bo) = a1; *(LAS v2u*)(VTP + (2 * c2 + 1) * 128 + (((chunk0 + 1) ^ sz) << 4) + bo) = b1; }
        if (item + F.G < NCH * NH) HC_FETCH(item + F.G);
        __syncthreads();
        f32x16 O;
#pragma unroll
        for (int i = 0; i < 16; ++i) O[i] = 0.f;
        {
#pragma unroll
          for (int ks = 0; ks < 8; ++ks) { const bf16x8 qf = *(const LAS bf16x8*)(QHh + trow * 256 + (((2 * ks + hh) ^ (trow & 15)) << 4)); O = MFMA32(sfr[ks], qf, O); } }
#pragma unroll
        for (int sb = 0; sb < 2; ++sb) {
            if (sb <= tb) {
                f32x16 X;
#pragma unroll
                for (int i = 0; i < 16; ++i) X[i] = 0.f;
                const int srow_ = 32 * sb + l31;
#pragma unroll
                for (int ks = 0; ks < 8; ++ks) { const bf16x8 kf = *(const LAS bf16x8*)(KT + srow_ * 256 + (((2 * ks + hh) ^ (srow_ & 15)) << 4));
                    const bf16x8 qf = *(const LAS bf16x8*)(QT + trow * 256 + (((2 * ks + hh) ^ (trow & 15)) << 4)); X = MFMA32(kf, qf, X); }
                if (sb == tb) {
#pragma unroll
                    for (int i = 0; i < 16; ++i) X[i] = (crow(i, hh) <= l31) ? X[i] : 0.f; }
#pragma unroll
                for (int st = 0; st < 2; ++st) { const bf16x8 pf = pack8(X, st);
                    const bf16x8 vf = *(const LAS bf16x8*)(VTP + dv * 128 + (((sb * 4 + st * 2 + hh) ^ ((dv >> 1) & 7)) << 4)); O = MFMA32(vf, pf, O); }
            }
        }
        float ssq = 0.f;
#pragma unroll
        for (int i = 0; i < 16; ++i) ssq += O[i] * O[i];
        ssq += __shfl_xor(ssq, 32);
        if (hh == 0) SS[(tb * 4 + dvb) * 32 + l31] = ssq;
        __syncthreads();
        const float tot = (SS[(tb * 4 + 0) * 32 + l31] + SS[(tb * 4 + 1) * 32 + l31]) + (SS[(tb * 4 + 2) * 32 + l31] + SS[(tb * 4 + 3) * 32 + l31]);
        const float rstd = 1.0f / sqrtf(tot * (1.0f / HD) + EPS);
        const size_t r = (size_t)(64 * (cc - 1) + trow);
#pragma unroll
        for (int g4 = 0; g4 < 4; ++g4) { const int dv0 = dvb * 32 + 8 * g4 + 4 * hh;
            const f32x4 w = *(const f32x4*)(hg_norm + h * HD + dv0); const v2u gt = gtv[g4];
            v2u o; o.x = pk_bf16(O[4 * g4] * rstd * w.x * bflo(gt.x), O[4 * g4 + 1] * rstd * w.y * bfhi(gt.x)); o.y = pk_bf16(O[4 * g4 + 2] * rstd * w.z * bflo(gt.y), O[4 * g4 + 3] * rstd * w.w * bfhi(gt.y));
            *(v2u*)(MIXED + r * D + h * HD + dv0) = o; }
    }
    __syncthreads();
#undef HC_FETCH
}

__device__ __forceinline__ void kvprep_phase(const Frame& F, const float* kw) {
    const bf16* KVRAW = (const bf16*)(F.ws + AR_KVRAW); const bf16* KR = (const bf16*)(F.ws + AR_KR); const float* CT = (const float*)(F.ws + WS_COS); const float* ST = (const float*)(F.ws + WS_SIN);
    unsigned char* KH = F.ws + AR_KH; unsigned char* VT = F.ws + AR_VT;
    LAS unsigned char* KI = F.lds + RING_OFF;
    LAS bf16* VS = (LAS bf16*)(F.lds + RING_OFF + 24576);
    const int lane = F.lane;
    const float w0 = kw[lane], w1 = kw[64 + lane], w2 = kw[128 + lane];
    for (int item = F.vcu; item < NKT * NH; item += F.G) {
        const int t = item >> 4, h = item & 15;
#pragma unroll 2
        for (int i = 0; i < 8; ++i) {
            const int kk = 8 * F.wave + i, p = 64 * t + kk; const bool valid = p < LTOT; const int r = p < 16 ? SEQ + p : p - 16;
            float x0 = 0.f, x1 = 0.f, x2 = 0.f; unsigned vv = 0u;
            if (valid) { const bf16* src = KVRAW + (size_t)r * 4096 + h * 256; x0 = bf2f(src[lane]); x1 = bf2f(src[64 + lane]); x2 = bf2f(KR[(size_t)r * RD + lane]); vv = *(const unsigned*)(src + 128 + 2 * lane); }
            const float rstd = 1.0f / sqrtf(wave_sum(x0 * x0 + x1 * x1 + x2 * x2) * (1.0f / QKD) + EPS);
            x0 *= rstd * w0; x1 *= rstd * w1; x2 *= rstd * w2;
            const float other = __shfl_xor(x2, 32); const int pc = valid ? p : 0; const float c = CT[pc * 32 + (lane & 31)], s = ST[pc * 32 + (lane & 31)];
            x2 = (lane < 32) ? (x2 * c - other * s) : (x2 * c + other * s);
            const int sz = (kk >> 1) & 7;
#define KOFF(d) (kk * 384 + ((((d) >> 3) & ~7) << 4) + (((((d) >> 3) & 7) ^ sz) << 4) + (((d) & 7) << 1))
            *(LAS bf16*)(KI + KOFF(lane)) = f2bf(x0); *(LAS bf16*)(KI + KOFF(64 + lane)) = f2bf(x1); *(LAS bf16*)(KI + KOFF(128 + lane)) = f2bf(x2);
#undef KOFF
            *(LAS unsigned*)(VS + kk * 136 + 2 * lane) = vv;
        }
        __syncthreads();
        { v4u* dst = (v4u*)(KH + (size_t)(h * NKT + t) * 24576);
#pragma unroll
          for (int j = 0; j < 3; ++j) dst[F.tid + 512 * j] = *(const LAS v4u*)(KI + (F.tid + 512 * j) * 16); }
        { v4u* dst = (v4u*)(VT + (size_t)(h * NKT + t) * 16384);
#pragma unroll
          for (int j = 0; j < 2; ++j) { const int ch = F.tid + 512 * j, dv = ch >> 3, cpos = ch & 7, cl = cpos ^ ((dv >> 1) & 7), kb = cl >> 2, st = (cl >> 1) & 1, hh = cl & 1;
              const int k0 = 32 * kb + 16 * st + 4 * hh; unsigned short e[8];
#pragma unroll
              for (int q = 0; q < 8; ++q) e[q] = VS[(k0 + 8 * (q >> 2) + (q & 3)) * 136 + dv];
              v4u o; o.x = e[0] | ((unsigned)e[1] << 16); o.y = e[2] | ((unsigned)e[3] << 16); o.z = e[4] | ((unsigned)e[5] << 16); o.w = e[6] | ((unsigned)e[7] << 16);
              dst[ch] = o; } }
        __syncthreads();
    }
}

constexpr int ATT_KB = 24576, ATT_VB = 16384;
constexpr int ATT_VBASE = 3 * ATT_KB;
__device__ __forceinline__ void attn_issue_k(const Frame& F, const unsigned char* ktile, LAS unsigned char* buf) {
    unsigned lo = F.lane * 16; asm volatile("" : "+v"(lo));
#pragma unroll
    for (int j = 0; j < 3; ++j) __builtin_amdgcn_global_load_lds((const unsigned*)(ktile + (size_t)(F.wave * 3 + j) * 1024 + lo), (LAS unsigned*)(buf + (F.wave * 3 + j) * 1024), 16, 0, 0);
}
__device__ __forceinline__ void attn_issue_v(const Frame& F, const unsigned char* vtile, LAS unsigned char* buf) {
    unsigned lo = F.lane * 16; asm volatile("" : "+v"(lo));
#pragma unroll
    for (int j = 0; j < 2; ++j) __builtin_amdgcn_global_load_lds((const unsigned*)(vtile + (size_t)(F.wave * 2 + j) * 1024 + lo), (LAS unsigned*)(buf + (F.wave * 2 + j) * 1024), 16, 0, 0);
}
__device__ __forceinline__ float xhalf_max(float v) { const auto r = __builtin_amdgcn_permlane32_swap(__float_as_uint(v), __float_as_uint(v), false, false); return fmaxf(__uint_as_float(r[0]), __uint_as_float(r[1])); }
__device__ __forceinline__ float xhalf_sum(float v) { const auto r = __builtin_amdgcn_permlane32_swap(__float_as_uint(v), __float_as_uint(v), false, false); return __uint_as_float(r[0]) + __uint_as_float(r[1]); }

#define ATT_KLD(ks, r) (*(const LAS bf16x8*)(lds + (kbo + kof[(ks) & 3] + ((ks) >> 2) * 128 + (r) * 12288)))
#define ATT_LDK4(dst, g_) do { dst[0] = ATT_KLD(2 * (g_), 0); dst[1] = ATT_KLD(2 * (g_), 1); dst[2] = ATT_KLD(2 * (g_) + 1, 0); dst[3] = ATT_KLD(2 * (g_) + 1, 1); } while (0)
#define ATT_MMK4(src, g_) do { S0 = MFMA32(src[0], qf(2 * (g_)), S0); S1 = MFMA32(src[1], qf(2 * (g_)), S1); S0 = MFMA32(src[2], qf(2 * (g_) + 1), S0); S1 = MFMA32(src[3], qf(2 * (g_) + 1), S1); } while (0)
#define ATT_QK(t_, bcur_) do { \
    _Pragma("unroll") for (int i = 0; i < 16; ++i) { S0[i] = negM; S1[i] = negM; }     \
    if (64 * (t_) <= 16 + q0 + 31) { \
        const int kbo = (bcur_) * ATT_KB; \
        bf16x8 ka[4], kb[4], kc[4];                  \
        ATT_LDK4(ka, 0); __builtin_amdgcn_sched_barrier(0); ATT_LDK4(kb, 1); __builtin_amdgcn_sched_barrier(0); \
        ATT_LDK4(kc, 2); __builtin_amdgcn_sched_barrier(0); ATT_MMK4(ka, 0); __builtin_amdgcn_sched_barrier(0); \
        ATT_LDK4(ka, 3); __builtin_amdgcn_sched_barrier(0); ATT_MMK4(kb, 1); __builtin_amdgcn_sched_barrier(0); \
        ATT_LDK4(kb, 4); __builtin_amdgcn_sched_barrier(0); ATT_MMK4(kc, 2); __builtin_amdgcn_sched_barrier(0); \
        ATT_LDK4(kc, 5); __builtin_amdgcn_sched_barrier(0); ATT_MMK4(ka, 3); __builtin_amdgcn_sched_barrier(0); \
        ATT_MMK4(kb, 4); __builtin_amdgcn_sched_barrier(0); ATT_MMK4(kc, 5); __builtin_amdgcn_sched_barrier(0); } } while (0)

#define ATT_SMPV(t_, bcur_) do { if (64 * (t_) <= 16 + q0 + 31) { \
    if (64 * (t_) + 63 > 16 + q0) { const int dh = qpos - 64 * (t_) - 4 * hh;     \
        _Pragma("unroll") for (int i = 0; i < 16; ++i) { S0[i] = ((i & 3) + 8 * (i >> 2) <= dh) ? S0[i] : -__builtin_inff(); S1[i] = ((i & 3) + 8 * (i >> 2) + 32 <= dh) ? S1[i] : -__builtin_inff(); } } \
    float ps = 0.f; \
    _Pragma("unroll") for (int i = 0; i < 16; ++i) { S0[i] = __builtin_amdgcn_exp2f(S0[i]); S1[i] = __builtin_amdgcn_exp2f(S1[i]); ps += S0[i] + S1[i]; } \
    l_run += ps; \
    const bf16x8 p00 = pack8(S0, 0), p01 = pack8(S0, 1), p10 = pack8(S1, 0), p11 = pack8(S1, 1); \
    const int vbo = ATT_VBASE + (bcur_) * ATT_VB; \
    bf16x8 va[4], vb[4], vc[4]; \
    va[0] = ATT_VF(0, 0); va[1] = ATT_VF(0, 2); va[2] = ATT_VF(0, 4); va[3] = ATT_VF(0, 6); \
    __builtin_amdgcn_sched_barrier(0); \
    vb[0] = ATT_VF(1, 0); vb[1] = ATT_VF(1, 2); vb[2] = ATT_VF(1, 4); vb[3] = ATT_VF(1, 6); \
    __builtin_amdgcn_sched_barrier(0); \
    vc[0] = ATT_VF(2, 0); vc[1] = ATT_VF(2, 2); vc[2] = ATT_VF(2, 4); vc[3] = ATT_VF(2, 6); \
    __builtin_amdgcn_sched_barrier(0); \
    O0 = MFMA32(va[0], p00, O0); O0 = MFMA32(va[1], p01, O0); O0 = MFMA32(va[2], p10, O0); O0 = MFMA32(va[3], p11, O0); \
    __builtin_amdgcn_sched_barrier(0); \
    va[0] = ATT_VF(3, 0); va[1] = ATT_VF(3, 2); va[2] = ATT_VF(3, 4); va[3] = ATT_VF(3, 6); \
    __builtin_amdgcn_sched_barrier(0); \
    O1 = MFMA32(vb[0], p00, O1); O1 = MFMA32(vb[1], p01, O1); O1 = MFMA32(vb[2], p10, O1); O1 = MFMA32(vb[3], p11, O1); \
    __builtin_amdgcn_sched_barrier(0); \
    O2 = MFMA32(vc[0], p00, O2); O2 = MFMA32(vc[1], p01, O2); O2 = MFMA32(vc[2], p10, O2); O2 = MFMA32(vc[3], p11, O2); \
    __builtin_amdgcn_sched_barrier(0); \
    O3 = MFMA32(va[0], p00, O3); O3 = MFMA32(va[1], p01, O3); O3 = MFMA32(va[2], p10, O3); O3 = MFMA32(va[3], p11, O3); \
    __builtin_amdgcn_sched_barrier(0); } } while (0)
#define ATT_VF(dvb, c) (*(const LAS bf16x8*)(lds + (vbo + vof[(c) >> 1] + (dvb) * 4096)))
#define ATT_WAIT(n) asm volatile("s_waitcnt vmcnt(" #n ")" ::: "memory")
#define ATT_BAR() do { asm volatile("s_waitcnt lgkmcnt(0)" ::: "memory"); __builtin_amdgcn_s_barrier(); asm volatile("" ::: "memory"); } while (0)

__device__ __forceinline__ void attn_unit(const Frame& F, int h, int qb, const float* qw, float negM, bool desc) {
    unsigned char* wsl = F.ws; asm volatile("" : "+s"(wsl));
    const bf16* QRAW = (const bf16*)(wsl + AR_QRAW); const float* CT = (const float*)(wsl + WS_COS); const float* ST = (const float*)(wsl + WS_SIN);
    const unsigned char* KH = wsl + AR_KH + (size_t)h * NKT * ATT_KB; const unsigned char* VT = wsl + AR_VT + (size_t)h * NKT * ATT_VB;
    LAS unsigned char* lds = F.lds + RING_OFF;
    int lane = F.lane; asm volatile("" : "+v"(lane));
    const int hh = lane >> 5, l31 = lane & 31, sz = (l31 >> 1) & 7;
    const bool grpA = F.wave < 4;
    const int q0 = 256 * qb + 32 * F.wave;
    const int qpos = 16 + q0 + l31;
    const int nt = (256 * qb + 271) / 64 + 1;
    v4u qv[12];
#define qf(ks) (__builtin_bit_cast(bf16x8, qv[ks]))
    { const bf16* qrow = (QRAW + (size_t)q0 * 3072 + h * QKD) + (unsigned)(l31 * 3072 + 8 * hh);
#pragma unroll
      for (int ks = 0; ks < 12; ++ks) qv[ks] = *(const v4u*)(qrow + 16 * ks);
      { const int ta = desc ? nt - 1 : 0, tb2 = desc ? nt - 2 : 1;
        attn_issue_k(F, KH + (size_t)ta * ATT_KB, lds); attn_issue_v(F, VT + (size_t)ta * ATT_VB, lds + ATT_VBASE);
        attn_issue_k(F, KH + (size_t)tb2 * ATT_KB, lds + ATT_KB); attn_issue_v(F, VT + (size_t)tb2 * ATT_VB, lds + ATT_VBASE + ATT_VB); }
      float ss = 0.f;
#pragma unroll
      for (int ks = 0; ks < 12; ++ks) { const v4u w = qv[ks]; const float a0 = bflo(w.x), a1 = bfhi(w.x), a2 = bflo(w.y), a3 = bfhi(w.y), a4 = bflo(w.z), a5 = bfhi(w.z), a6 = bflo(w.w), a7 = bfhi(w.w);
          ss += (a0 * a0 + a1 * a1) + (a2 * a2 + a3 * a3) + (a4 * a4 + a5 * a5) + (a6 * a6 + a7 * a7); }
      ss = xhalf_sum(ss);
#pragma unroll
      for (int ks = 0; ks < 12; ++ks) asm volatile("" : "+v"(qv[ks]));
      const float rs = QSCALE / sqrtf(ss * (1.0f / QKD) + EPS);
#pragma unroll
      for (int ks = 0; ks < 8; ++ks) { const v4u w = qv[ks]; const f32x4 g0 = *(const f32x4*)(qw + 16 * ks + 8 * hh), g1 = *(const f32x4*)(qw + 16 * ks + 8 * hh + 4);
          v4u o; o.x = pk_bf16(bflo(w.x) * rs * g0[0], bfhi(w.x) * rs * g0[1]); o.y = pk_bf16(bflo(w.y) * rs * g0[2], bfhi(w.y) * rs * g0[3]);
          o.z = pk_bf16(bflo(w.z) * rs * g1[0], bfhi(w.z) * rs * g1[1]); o.w = pk_bf16(bflo(w.w) * rs * g1[2], bfhi(w.w) * rs * g1[3]); qv[ks] = o;
          if (ks & 1) asm volatile("" ::: "memory"); }
#pragma unroll
      for (int a = 0; a < 2; ++a) {
          const v4u w1 = qv[8 + a], w2 = qv[10 + a]; const int i0 = 16 * a + 8 * hh;
          const f32x4 ga0 = *(const f32x4*)(qw + 128 + i0), ga1 = *(const f32x4*)(qw + 128 + i0 + 4), gb0 = *(const f32x4*)(qw + 160 + i0), gb1 = *(const f32x4*)(qw + 160 + i0 + 4);
          const float* ctp = (CT + (size_t)(16 + q0) * 32 + 16 * a) + (unsigned)(l31 * 32 + 8 * hh); const float* stp = (ST + (size_t)(16 + q0) * 32 + 16 * a) + (unsigned)(l31 * 32 + 8 * hh);
          const f32x4 c0 = *(const f32x4*)ctp, c1 = *(const f32x4*)(ctp + 4), s0 = *(const f32x4*)stp, s1 = *(const f32x4*)(stp + 4);
          float x1[8] = {bflo(w1.x) * ga0[0], bfhi(w1.x) * ga0[1], bflo(w1.y) * ga0[2], bfhi(w1.y) * ga0[3], bflo(w1.z) * ga1[0], bfhi(w1.z) * ga1[1], bflo(w1.w) * ga1[2], bfhi(w1.w) * ga1[3]};
          float x2[8] = {bflo(w2.x) * gb0[0], bfhi(w2.x) * gb0[1], bflo(w2.y) * gb0[2], bfhi(w2.y) * gb0[3], bflo(w2.z) * gb1[0], bfhi(w2.z) * gb1[1], bflo(w2.w) * gb1[2], bfhi(w2.w) * gb1[3]};
          const float cc[8] = {c0[0], c0[1], c0[2], c0[3], c1[0], c1[1], c1[2], c1[3]}, sn[8] = {s0[0], s0[1], s0[2], s0[3], s1[0], s1[1], s1[2], s1[3]};
          float y1[8], y2[8];
#pragma unroll
          for (int j = 0; j < 8; ++j) { y1[j] = (x1[j] * cc[j] - x2[j] * sn[j]) * rs; y2[j] = (x2[j] * cc[j] + x1[j] * sn[j]) * rs; }
          v4u o1, o2; o1.x = pk_bf16(y1[0], y1[1]); o1.y = pk_bf16(y1[2], y1[3]); o1.z = pk_bf16(y1[4], y1[5]); o1.w = pk_bf16(y1[6], y1[7]);
          o2.x = pk_bf16(y2[0], y2[1]); o2.y = pk_bf16(y2[2], y2[3]); o2.z = pk_bf16(y2[4], y2[5]); o2.w = pk_bf16(y2[6], y2[7]);
          qv[8 + a] = o1; qv[10 + a] = o2; asm volatile("" ::: "memory"); }
    }
    int kof[4], vof[4];
#pragma unroll
    for (int c2 = 0; c2 < 4; ++c2) { const int slot = (((2 * c2 + hh) ^ sz) & 7) << 4; kof[c2] = l31 * 384 + slot; vof[c2] = l31 * 128 + slot; }
    f32x16 O0, O1, O2, O3, S0, S1;
#pragma unroll
    for (int i = 0; i < 16; ++i) { O0[i] = 0.f; O1[i] = 0.f; O2[i] = 0.f; O3[i] = 0.f; S0[i] = 0.f; S1[i] = 0.f; }
    float l_run = 0.f;
    ATT_WAIT(7); ATT_BAR();
#define ATT_TILE(i_) (desc ? nt - 1 - (i_) : (i_))
#define ATT_ISSUE_K() attn_issue_k(F, KH + (size_t)ATT_TILE((t + 2 < nt) ? t + 2 : nt - 1) * ATT_KB, lds + b2 * ATT_KB)
#define ATT_ISSUE_V() attn_issue_v(F, VT + (size_t)ATT_TILE((t + 2 < nt) ? t + 2 : nt - 1) * ATT_VB, lds + ATT_VBASE + b2 * ATT_VB)
#define ATT_ROT() do { bp = b0; b0 = (b0 == 2) ? 0 : b0 + 1; b2 = (b2 == 2) ? 0 : b2 + 1; } while (0)
    int b0 = 0, b2 = 2, bp = 2;
    if (grpA) {
#pragma unroll 1
        for (int t = 0; t < nt; ++t) {
            const int tl = ATT_TILE(t);
            ATT_ISSUE_K(); ATT_QK(tl, b0); ATT_WAIT(8); ATT_BAR();
            ATT_ISSUE_V(); ATT_SMPV(tl, b0); ATT_WAIT(7); ATT_BAR();
            ATT_ROT();
        }
    } else {
#pragma unroll 1
        for (int t = 0; t < nt; ++t) {
            const int tl = ATT_TILE(t), tlp = ATT_TILE(t - 1);
            ATT_ISSUE_K(); if (t > 0) { ATT_SMPV(tlp, bp); } ATT_WAIT(8); ATT_BAR();
            ATT_ISSUE_V(); ATT_QK(tl, b0); ATT_WAIT(7); ATT_BAR();
            ATT_ROT();
        }
        { const int tll = ATT_TILE(nt - 1); ATT_SMPV(tll, bp); }
    }
#undef ATT_ROT
#undef ATT_TILE
#undef ATT_ISSUE_K
#undef ATT_ISSUE_V
    ATT_WAIT(0); ATT_BAR();
    const float inv = 1.0f / xhalf_sum(l_run);
    bf16* orow = ((bf16*)(wsl + AR_MIXED) + (size_t)q0 * D + HGW + h * HD) + (unsigned)(l31 * D + 4 * hh);
#pragma unroll
    for (int g4 = 0; g4 < 4; ++g4) {
        v2u o;
        o.x = pk_bf16(O0[4 * g4] * inv, O0[4 * g4 + 1] * inv); o.y = pk_bf16(O0[4 * g4 + 2] * inv, O0[4 * g4 + 3] * inv); *(v2u*)(orow + 0 + 8 * g4) = o;
        o.x = pk_bf16(O1[4 * g4] * inv, O1[4 * g4 + 1] * inv); o.y = pk_bf16(O1[4 * g4 + 2] * inv, O1[4 * g4 + 3] * inv); *(v2u*)(orow + 32 + 8 * g4) = o;
        o.x = pk_bf16(O2[4 * g4] * inv, O2[4 * g4 + 1] * inv); o.y = pk_bf16(O2[4 * g4 + 2] * inv, O2[4 * g4 + 3] * inv); *(v2u*)(orow + 64 + 8 * g4) = o;
        o.x = pk_bf16(O3[4 * g4] * inv, O3[4 * g4 + 1] * inv); o.y = pk_bf16(O3[4 * g4 + 2] * inv, O3[4 * g4 + 3] * inv); *(v2u*)(orow + 96 + 8 * g4) = o;
    }
}
#undef ATT_QK
#undef qf
#undef ATT_KLD
#undef ATT_LDK4
#undef ATT_MMK4
#undef ATT_SMPV
#undef ATT_VF
#undef ATT_WAIT
#undef ATT_BAR
__device__ __forceinline__ void attn_phase(const Frame& F, const float* qw, const float* kw) {
    float gq = fmaxf(fmaxf(fabsf(qw[F.lane]), fabsf(qw[64 + F.lane])), fabsf(qw[128 + F.lane])), gk = fmaxf(fmaxf(fabsf(kw[F.lane]), fabsf(kw[64 + F.lane])), fabsf(kw[128 + F.lane]));
#pragma unroll
    for (int o = 1; o < 64; o <<= 1) { gq = fmaxf(gq, __shfl_xor(gq, o)); gk = fmaxf(gk, __shfl_xor(gk, o)); }
    const float negM = -(1.01f * 13.856406460551018f * 1.4426950408889634f) * gq * gk;
    if (F.wave >= 4) __builtin_amdgcn_s_setprio(1);
    for (int item = F.vcu; item < NH * 32; item += F.G) {
        const int h = item >> 5, pr = item & 31;
#pragma unroll 1
        for (int u = 0; u < 2; ++u) attn_unit(F, h, u ? pr : 63 - pr, qw, negM, false);
    }
    __builtin_amdgcn_s_setprio(0);
}

constexpr int N_PHASES = 14;
#ifndef WGM_GU
#define WGM_GU 8
#endif
#ifndef WGM_IN
#define WGM_IN 8
#endif
#ifndef WGM_DOWN
#define WGM_DOWN 4
#endif
#ifndef PROBE_PHASE
#define PROBE_PHASE -1
#endif
#define REP(k) for (int rep_ = 0; rep_ < ((PROBE_PHASE == (k)) ? 2 : 1); ++rep_)
#define RSCALE(k, s) ((PROBE_PHASE == (k) && rep_ == 0) ? 0.0f : (s))
__global__ void __launch_bounds__(NWAVES * 64, 2) fwd_kernel(Args args) {
    extern __shared__ __attribute__((aligned(16))) unsigned char lds_raw[];
    Frame F;
    F.lds = (LAS unsigned char*)lds_raw;
    F.tid = threadIdx.x; F.lane = F.tid & 63; F.wave = __builtin_amdgcn_readfirstlane(F.tid >> 6);
    F.G = gridDim.x; { const int bx = blockIdx.x; F.vcu = (F.G % 8 == 0) ? (bx % 8) * (F.G / 8) + bx / 8 : bx; }
    F.ws = args.ws; F.out = args.out;
    unsigned char* ws = args.ws;
    for (int u = F.tid; u < (LDS_BYTES - LDSCTL_OFF) / 4; u += NWAVES * 64) ((LAS unsigned*)(F.lds + LDSCTL_OFF))[u] = 0u;
    __syncthreads();
    XcdBarrier bar; bar.bar = (unsigned*)(ws + WS_CTL) + CW_BAR; bar.x = 0; bar.st = nullptr;
    const int lo = args.ph_lo, hi = args.ph_hi;
    if (hi - lo > 1) bar = xcd_barrier_post((unsigned*)(ws + WS_CTL) + CW_BAR, (volatile LAS unsigned*)(F.lds + MISC_OFF) + 8);
#define IN(k) (lo <= (k) && (k) < hi)
#define SEAM(k) do { if (IN(k) && IN((k) + 1)) xcd_barrier(bar); { int t_ = threadIdx.x; asm volatile("" : "+v"(t_)); F.tid = t_; F.lane = t_ & 63; } } while (0)
    float* HM = (float*)(ws + WS_HM);
    bf16* XN = (bf16*)(ws + AR_XN); bf16* ACT = (bf16*)(ws + AR_ACT);

    float* STAT1 = (float*)(ws + WS_CTL + CTL_STAT1); float* STAT2 = (float*)(ws + WS_CTL + CTL_STAT2);

    if (IN(0)) REP(0) { p0_prologue(F, args); __syncthreads(); } SEAM(0);

    if (IN(1)) REP(1) {
        pg8::Gemm g{XN, (const bf16*)(ws + WS_W1GU), MP, 2 * DFF, D}; pg8::StaticOrder S; S.init(MP, 2 * DFF, F.G, (int)blockIdx.x, WGM_GU);
        pg8::EpiSwiglu<false> E{ACT, DFF, nullptr};
        pg8::gemm_phase<pg8::EpiSwiglu<false>, pg8::StaticOrder, true, true>(F.lds + RING_OFF, g, S, E);
    } SEAM(1);

    if (IN(2)) {
        pg8::Gemm g{ACT, (const bf16*)(ws + WS_W1D), SEQ, D, DFF}; pg8::StaticOrder S; S.init(SEQ, D, F.G, (int)blockIdx.x, WGM_DOWN);
        typedef pg8::EpiResid<true, AR_XN, WS_CTL + CTL_STAT1, WS_G1> Epi; Epi E{args.in[0], F.out, D, 0.5f, ws};
        pg8::gemm_phase<Epi, pg8::StaticOrder, true, true>(F.lds + RING_OFF, g, S, E);
        meta_down_phase(F, ACT, (const bf16*)(ws + WS_W1D), HM, 0.5f, XN, STAT1, (const float*)(ws + WS_G1));
    } SEAM(2);

    if (IN(3)) REP(3) {
        zero_null_rows(F);
        pg8::Gemm g{XN, (const bf16*)(ws + WS_WIN), MP, INCP, D}; pg8::StaticOrder S; S.init(MP, INCP, F.G, (int)blockIdx.x, WGM_IN);
        pg8::EpiWin E{(bf16*)(ws + AR_HQ), (bf16*)(ws + AR_HV), (bf16*)(ws + AR_G), (bf16*)(ws + AR_CQ), (bf16*)(ws + AR_CKV), (bf16*)(ws + AR_KR), (float*)(ws + AR_LOGF), (const float*)(ws + WS_LB), STAT1};
        pg8::gemm_phase<pg8::EpiWin, pg8::StaticOrder, true, true>(F.lds + RING_OFF, g, S, E);
    } SEAM(3);

    if (IN(4)) REP(4) {
        lat_norm<QL>(F, (const bf16*)(ws + AR_CQ), args.in[10], (bf16*)(ws + AR_CQN), LTOT, MP);
        lat_norm<KVL>(F, (const bf16*)(ws + AR_CKV), args.in[12], (bf16*)(ws + AR_CKVN), LTOT, MP);
        hgrn_pass_a(F);
    } SEAM(4);

    if (IN(5)) { hgrn_pass_b(F); } SEAM(5);
    if (IN(6)) REP(6) { hgrn_pass_c(F, args.in[9]); } SEAM(6);

    if (IN(7)) REP(7) {
        { pg8::Gemm g{(const bf16*)(ws + AR_CQN), (const bf16*)(ws + WS_WUQ), SEQ, 3072, QL}; pg8::StaticOrder S; S.init(SEQ, 3072, F.G, (int)blockIdx.x);
          pg8::EpiPlain E{(bf16*)(ws + AR_QRAW), 3072};
          pg8::gemm_phase<pg8::EpiPlain, pg8::StaticOrder, true, true>(F.lds + RING_OFF, g, S, E); }
        { pg8::Gemm g{(const bf16*)(ws + AR_CKVN), (const bf16*)(ws + WS_WUKV), MP, 4096, KVL}; pg8::StaticOrder S; S.init(MP, 4096, F.G, (int)blockIdx.x);
          pg8::EpiPlain E{(bf16*)(ws + AR_KVRAW), 4096};
          pg8::gemm_phase<pg8::EpiPlain, pg8::StaticOrder, true, true>(F.lds + RING_OFF, g, S, E); }
    } SEAM(7);

    if (IN(8)) REP(8) { kvprep_phase(F, args.in[15]); } SEAM(8);

    if (IN(9)) { attn_phase(F, args.in[14], args.in[15]); if (PROBE_PHASE == 9) attn_phase(F, args.in[14], args.in[15]); } SEAM(9);

    if (IN(10)) {
        pg8::Gemm g{(const bf16*)(ws + AR_MIXED), (const bf16*)(ws + WS_WOUT), SEQ, D, D}; pg8::StaticOrder S; S.init(SEQ, D, F.G, (int)blockIdx.x, WGM_DOWN);
        typedef pg8::EpiResid<true, AR_XN2, WS_CTL + CTL_STAT2, WS_G2> Epi; Epi E{F.out, F.out, D, 1.0f, ws};
        pg8::gemm_phase<Epi, pg8::StaticOrder, true, true>(F.lds + RING_OFF, g, S, E);
    } SEAM(10);

    if (IN(11)) REP(11) {
        pg8::Gemm g{(const bf16*)(ws + AR_XN2), (const bf16*)(ws + WS_W2GU), SEQ, 2 * DFF, D}; pg8::StaticOrder S; S.init(SEQ, 2 * DFF, F.G, (int)blockIdx.x, WGM_GU);
        pg8::EpiSwiglu<true> E{ACT, DFF, STAT2};
        pg8::gemm_phase<pg8::EpiSwiglu<true>, pg8::StaticOrder, true, true>(F.lds + RING_OFF, g, S, E);
    } SEAM(11);

    if (IN(12)) {
        pg8::Gemm g{ACT, (const bf16*)(ws + WS_W2D), SEQ, D, DFF}; pg8::StaticOrder S; S.init(SEQ, D, F.G, (int)blockIdx.x, WGM_DOWN);
        typedef pg8::EpiResid<false, 0, 0, 0> Epi; Epi E{F.out, F.out, D, 0.5f, ws};
        pg8::gemm_phase<Epi, pg8::StaticOrder, true, true>(F.lds + RING_OFF, g, S, E);
    } SEAM(12);

    if (IN(13)) { final_norm(F, args.in[21]); }
#undef IN
#undef SEAM
}

extern "C" void kernel_launch(void* const* d_in, const int* in_sizes, int n_in, void* d_out, int out_size, void* d_ws, size_t ws_size, hipStream_t stream) {
    static int grid = 0;
    if (grid == 0) {
        if (n_in != 22 || out_size != SEQ * D || ws_size < WS_END) { fprintf(stderr, "kernel_launch: unexpected shapes (n_in %d, out %d, ws %zu < %zu)\n", n_in, out_size, ws_size, (size_t)WS_END); grid = -1; return; }
        int dev = 0, cus = 0, per_cu = 0;
        if (hipGetDevice(&dev) != hipSuccess || hipDeviceGetAttribute(&cus, hipDeviceAttributeMultiprocessorCount, dev) != hipSuccess) { grid = -1; return; }
        if (hipFuncSetAttribute((const void*)fwd_kernel, hipFuncAttributeMaxDynamicSharedMemorySize, LDS_BYTES) != hipSuccess) { fprintf(stderr, "kernel_launch: hipFuncSetAttribute failed\n"); grid = -1; return; }
        if (hipOccupancyMaxActiveBlocksPerMultiprocessor(&per_cu, (const void*)fwd_kernel, NWAVES * 64, LDS_BYTES) != hipSuccess || per_cu < 1) fprintf(stderr, "kernel_launch: occupancy query says %d\n", per_cu);
        (void)hipGetLastError();
        grid = cus;
    }
    if (grid < 0) return;
    if (hipMemsetAsync((char*)d_ws + WS_CTL, 0, CTL_ZERO_BYTES, stream) != hipSuccess) return;
    Args a{};
    for (int i = 0; i < 22; ++i) a.in[i] = (const float*)d_in[i];
    a.out = (float*)d_out; a.ws = (unsigned char*)d_ws;
#if MK_SINGLE
    a.ph_lo = 0; a.ph_hi = N_PHASES;
    hipLaunchKernelGGL(fwd_kernel, dim3(grid), dim3(NWAVES * 64), LDS_BYTES, stream, a);
#else
    for (int p = 0; p < N_PHASES; ++p) { a.ph_lo = p; a.ph_hi = p + 1; hipLaunchKernelGGL(fwd_kernel, dim3(grid), dim3(NWAVES * 64), LDS_BYTES, stream, a); }
#endif
}
```

```cpp
#include <hip/hip_runtime.h>
#include <cstdio>
#include <cstdint>
#ifndef MK_SINGLE
#define MK_SINGLE 1
#endif
namespace pg8 {
#define PG8_LAS __attribute__((address_space(3)))
typedef unsigned short bf16_t;
typedef short bf16x8 __attribute__((ext_vector_type(8)));
typedef float f32x4 __attribute__((ext_vector_type(4)));
typedef unsigned u32x4 __attribute__((ext_vector_type(4)));
constexpr int BM = 256, BK = 64, HALF = 128, HTB = HALF * BK * 2  , STAGE_BYTES = 8 * HTB, NXCD = 8, WGM = 8;

__host__ __device__ __forceinline__ int lds_byte(int r, int c) { const int st = (r >> 4) * 2 + (c >> 5), rr = r & 15, cc = c & 31, ob = rr * 64 + cc * 2; return st * 1024 + (ob ^ (((ob >> 9) & 1) << 5)); }
__host__ __device__ __forceinline__ void stage_rc(int b, int& R, int& C) { const int st = b / 1024, sb = b % 1024, swz = sb ^ (((sb >> 9) & 1) << 5); R = (st >> 1) * 16 + swz / 64; C = (st & 1) * 32 + (swz % 64) / 2; }
__host__ __device__ __forceinline__ int perm32(int rho) { const int n = rho >> 4, i = rho & 15; return 8 * (i >> 2) + 4 * n + (i & 3); }

struct Unit { int pm, pn; };
struct Gemm { const bf16_t* A; const bf16_t* Bt; int M, N, K; };

struct StaticOrder {
    int nM, nN, nwg, G, c, wgm;
    __host__ __device__ void init(int M, int N, int G_, int c_, int wgm_ = WGM) { nM = M / BM; nN = N / BM; nwg = nM * nN; G = G_; c = c_; wgm = wgm_; }
    __host__ __device__ bool next(int i, Unit& u) const {
        const long L = (long)i * G + c; if (L >= nwg) return false;
        int wgid = (int)L; { const int q = nwg / NXCD, r = nwg % NXCD, xcd = wgid % NXCD, off = wgid / NXCD; wgid = (xcd < r ? xcd * (q + 1) : r * (q + 1) + (xcd - r) * q) + off; }
        const int nig = wgm * nN, gid = wgid / nig, fm = gid * wgm, gsz = (nM - fm) < wgm ? (nM - fm) : wgm;
        u.pm = fm + ((wgid % nig) % gsz); u.pn = (wgid % nig) / gsz; return true;
    }
    __device__ __forceinline__ void a_ready(const Unit&) const {}
    __device__ __forceinline__ void done(const Unit&) const {}
};

__device__ __forceinline__ unsigned cvt_pk_bf16(float lo, float hi) { unsigned r; asm volatile("v_cvt_pk_bf16_f32 %0, %1, %2" : "=v"(r) : "v"(lo), "v"(hi)); return r; }
typedef float f32x2 __attribute__((ext_vector_type(2)));

__device__ __forceinline__ unsigned pk_bf16(float lo, float hi) {
    typedef __bf16 bf2_t __attribute__((ext_vector_type(2))); const f32x2 v = {lo, hi}; return __builtin_bit_cast(unsigned, __builtin_convertvector(v, bf2_t)); }
__device__ __forceinline__ float fsigmoid(float x) { return __builtin_amdgcn_rcpf(1.0f + __builtin_amdgcn_exp2f(-1.4426950408889634f * x)); }
__device__ __forceinline__ float fsilu(float x) { return x * fsigmoid(x); }

template <bool RS> struct EpiSwiglu {
    static constexpr bool PERM = true, AFTER_DRAIN = false;
    bf16_t* O; int ldc; const float* stat;
    __device__ __forceinline__ void operator()(const f32x4 (&acc)[2][2][4][2], const Unit& u, int wr, int wc, int fr, int fq) const {
        const int row0 = u.pm * BM + wr * 64 + fr, col0 = u.pn * HALF + wc * 32 + 8 * fq;
#pragma unroll
        for (int ai = 0; ai < 2; ++ai)
#pragma unroll
            for (int m = 0; m < 4; ++m) { const int row = row0 + ai * HALF + m * 16; bf16_t* rowp = O + (size_t)row * ldc + col0;
                f32x4 g0 = acc[ai][0][m][0], g1 = acc[ai][0][m][1], u0 = acc[ai][1][m][0], u1 = acc[ai][1][m][1];
                if (RS) { const float rs = 1.0f / sqrtf(stat[row] * (1.0f / 4096.0f) + 1e-6f); g0 *= rs; g1 *= rs; u0 *= rs; u1 *= rs; }
                u32x4 w; w.x = pk_bf16(fsilu(g0[0]) * u0[0], fsilu(g0[1]) * u0[1]); w.y = pk_bf16(fsilu(g0[2]) * u0[2], fsilu(g0[3]) * u0[3]);
                w.z = pk_bf16(fsilu(g1[0]) * u1[0], fsilu(g1[1]) * u1[1]); w.w = pk_bf16(fsilu(g1[2]) * u1[2], fsilu(g1[3]) * u1[3]);
                *(u32x4*)rowp = w; }
    }
};
template <bool COPY, size_t XBOFF, size_t STOFF, size_t GOFF> struct EpiResid {
    static constexpr bool PERM = false, AFTER_DRAIN = false;
    const float* base; float* out; int ldc; float scale; unsigned char* ws;
    __device__ __forceinline__ void operator()(const f32x4 (&acc)[2][2][4][2], const Unit& u, int wr, int wc, int fr, int fq) const {
        const int row0 = u.pm * BM + wr * 64 + fr, col0 = u.pn * BM + wc * 32 + 4 * fq;
        bf16_t* XB = (bf16_t*)(ws + XBOFF); float* stat = (float*)(ws + STOFF); const float* gain = (const float*)(ws + GOFF);
        typedef unsigned u32x2_ __attribute__((ext_vector_type(2)));
        f32x4 pre[2][2][2][2]; float ssq[8];
#define ER_LOAD(q, buf) do { _Pragma("unroll") for (int mm = 0; mm < 2; ++mm) { const size_t off_ = (size_t)(row0 + ((q) >> 1) * HALF + (2 * ((q) & 1) + mm) * 16) * ldc + col0; \
            _Pragma("unroll") for (int bj = 0; bj < 2; ++bj) _Pragma("unroll") for (int n = 0; n < 2; ++n) pre[buf][mm][bj][n] = *(const f32x4*)(base + off_ + bj * HALF + n * 16); } } while (0)
        ER_LOAD(0, 0);
#pragma unroll
        for (int q = 0; q < 4; ++q) {
            if (q == 0) ER_LOAD(1, 1); else if (q == 1) ER_LOAD(2, 0); else if (q == 2) ER_LOAD(3, 1);
#pragma unroll
            for (int mm = 0; mm < 2; ++mm) { const int ai = q >> 1, m = 2 * (q & 1) + mm; const size_t off = (size_t)(row0 + ai * HALF + m * 16) * ldc + col0; float ss = 0.f;
#pragma unroll
                for (int bj = 0; bj < 2; ++bj)
#pragma unroll
                    for (int n = 0; n < 2; ++n) {
                        const f32x4 o = pre[q & 1][mm][bj][n] + acc[ai][bj][m][n] * scale;
                        *(f32x4*)(out + off + bj * HALF + n * 16) = o;
                        if (COPY) { const f32x4 gn = *(const f32x4*)(gain + col0 + bj * HALF + n * 16); u32x2_ w; w.x = pk_bf16(o[0] * gn[0], o[1] * gn[1]); w.y = pk_bf16(o[2] * gn[2], o[3] * gn[3]); *(u32x2_*)(XB + off + bj * HALF + n * 16) = w; ss += (o[0] * o[0] + o[1] * o[1]) + (o[2] * o[2] + o[3] * o[3]); } }
                if (COPY) { ss += __shfl_xor(ss, 16); ss += __shfl_xor(ss, 32); ssq[2 * q + mm] = ss; } }
        }
#undef ER_LOAD
        if (COPY) { if (fq == 0) {
#pragma unroll
            for (int i = 0; i < 8; ++i) atomicAdd(stat + row0 + (i >> 2) * HALF + (i & 3) * 16, ssq[i]); } }
    }
};
struct EpiPlain {
    static constexpr bool PERM = true, AFTER_DRAIN = false;
    bf16_t* O; int ldc;
    __device__ __forceinline__ void operator()(const f32x4 (&acc)[2][2][4][2], const Unit& u, int wr, int wc, int fr, int fq) const {
        const int row0 = u.pm * BM + wr * 64 + fr, col0 = u.pn * BM + wc * 32 + 8 * fq;
#pragma unroll
        for (int ai = 0; ai < 2; ++ai)
#pragma unroll
            for (int m = 0; m < 4; ++m) { bf16_t* rowp = O + (size_t)(row0 + ai * HALF + m * 16) * ldc + col0;
#pragma unroll
                for (int bj = 0; bj < 2; ++bj) { const f32x4 v0 = acc[ai][bj][m][0], v1 = acc[ai][bj][m][1];
                    u32x4 w; w.x = pk_bf16(v0[0], v0[1]); w.y = pk_bf16(v0[2], v0[3]); w.z = pk_bf16(v1[0], v1[1]); w.w = pk_bf16(v1[2], v1[3]);
                    *(u32x4*)(rowp + bj * HALF) = w; } }
    }
};
struct EpiWin {
    static constexpr bool PERM = true, AFTER_DRAIN = false;
    bf16_t *HQ, *HV, *G, *CQ, *CKV, *KR; float* LOGF; const float* lb; const float* stat;
    __device__ __forceinline__ void operator()(const f32x4 (&acc)[2][2][4][2], const Unit& u, int wr, int wc, int fr, int fq) const {
        const int pn = u.pn;
        int mode, ld, cbase, espace; bf16_t* dst = nullptr;
        if (pn < 8)       { mode = 1; dst = HQ;  ld = 2048; cbase = pn * 256;        espace = 1; }
        else if (pn < 16) { mode = 2; dst = nullptr; ld = 2048; cbase = (pn - 8) * 256;  espace = 1; }
        else if (pn < 24) { mode = 0; dst = HV;  ld = 2048; cbase = (pn - 16) * 256; espace = 1; }
        else if (pn < 32) { mode = 1; dst = G;   ld = 2048; cbase = (pn - 24) * 256; espace = 0; }
        else if (pn < 36) { mode = 0; dst = CQ;  ld = 1024; cbase = (pn - 32) * 256; espace = 0; }
        else if (pn < 38) { mode = 0; dst = CKV; ld = 512;  cbase = (pn - 36) * 256; espace = 0; }
        else              { mode = 0; dst = KR;  ld = 64;   cbase = 0;               espace = 0; }
#pragma unroll
        for (int ai = 0; ai < 2; ++ai)
#pragma unroll
            for (int m = 0; m < 4; ++m) {
                const int r = u.pm * BM + ai * HALF + wr * 64 + m * 16 + fr;
                if (u.pm * BM + ai * HALF + wr * 64 + m * 16 >= 16400) continue;
                const int drow = espace ? (r < 16384 ? r + 64 : r - 16384 + 48) : r;
                const float rs = 1.0f / sqrtf(stat[r] * (1.0f / 4096.0f) + 1e-6f);
#pragma unroll
                for (int bj = 0; bj < 2; ++bj) {
                    const int c = bj * HALF + wc * 32 + 8 * fq;
                    if (pn == 38 && c >= 64) continue;
                    const f32x4 v0 = acc[ai][bj][m][0] * rs, v1 = acc[ai][bj][m][1] * rs;
                    if (mode == 2) {
                        const f32x4 l0 = *(const f32x4*)(lb + cbase + c), l1 = *(const f32x4*)(lb + cbase + c + 4); f32x4 o0, o1;
#pragma unroll
                        for (int j = 0; j < 4; ++j) { o0[j] = __logf(l0[j] + (1.0f - l0[j]) * fsigmoid(v0[j])); o1[j] = __logf(l1[j] + (1.0f - l1[j]) * fsigmoid(v1[j])); }
                        float* p = LOGF + (size_t)drow * ld + cbase + c; *(f32x4*)p = o0; *(f32x4*)(p + 4) = o1;
                    } else {
                        u32x4 w;
                        if (mode == 1) { w.x = pk_bf16(fsilu(v0[0]), fsilu(v0[1])); w.y = pk_bf16(fsilu(v0[2]), fsilu(v0[3])); w.z = pk_bf16(fsilu(v1[0]), fsilu(v1[1])); w.w = pk_bf16(fsilu(v1[2]), fsilu(v1[3])); }
                        else { w.x = pk_bf16(v0[0], v0[1]); w.y = pk_bf16(v0[2], v0[3]); w.z = pk_bf16(v1[0], v1[1]); w.w = pk_bf16(v1[2], v1[3]); }
                        *(u32x4*)(dst + (size_t)drow * ld + cbase + c) = w;
                    }
                }
            }
    }
};
template <class Epi, class Sched, bool ALIGN_EPI = false, bool SP2 = false>
__device__ __forceinline__ void gemm_phase(PG8_LAS unsigned char* lds, const Gemm g, const Sched& S, const Epi& E) {
    const int tid = threadIdx.x, wid = __builtin_amdgcn_readfirstlane(tid >> 6), lane = tid & 63, wr = wid >> 2, wc = wid & 3, fr = lane & 15, fq = lane >> 4;
    const int K = g.K, nt = K / BK;
    unsigned voffA[2], voffB[2];
#pragma unroll
    for (int i = 0; i < 2; ++i) { int R, C; stage_rc(tid * 16 + i * 8192, R, C); const int Rb = Epi::PERM ? ((R & ~31) + perm32(R & 31)) : R;
        voffA[i] = (unsigned)(R * K + C) * 2u; voffB[i] = (unsigned)(Rb * K + C) * 2u; }
    const size_t kstep = (size_t)(BK * 2);
    const size_t hstep = (size_t)HALF * K * 2;
    const size_t tstep = 2 * hstep;
    const unsigned ldsw = (unsigned)wid * 1024u;
    const int aoff = lds_byte(wr * 64 + fr, fq * 8), boff = lds_byte(wc * 32 + fr, fq * 8);
#define PG8_SA(b, h) (((b) * 2 + (h)) * HTB)
#define PG8_SB(b, h) ((4 + (b) * 2 + (h)) * HTB)
#define PG8_STAGE(bufoff, gbase, voff) do { _Pragma("unroll") for (int _i = 0; _i < 2; ++_i) \
        __builtin_amdgcn_global_load_lds((const unsigned*)((const char*)(gbase) + (voff)[_i]), (PG8_LAS unsigned*)(lds + (bufoff) + ldsw + _i * 8192), 16, 0, 0); } while (0)
#define PG8_LDA(dst, b, h) do { _Pragma("unroll") for (int m = 0; m < 4; ++m) _Pragma("unroll") for (int k = 0; k < 2; ++k) dst[m][k] = *(const PG8_LAS bf16x8*)(lds + PG8_SA(b, h) + aoff + m * 2048 + k * 1024); } while (0)
#define PG8_LDB(dst, b, h) do { _Pragma("unroll") for (int n = 0; n < 2; ++n) _Pragma("unroll") for (int k = 0; k < 2; ++k) dst[n][k] = *(const PG8_LAS bf16x8*)(lds + PG8_SB(b, h) + boff + n * 2048 + k * 1024); } while (0)
#define PG8_MMA(ai, bj, At, Bt) do { __builtin_amdgcn_s_setprio(1); _Pragma("unroll") for (int m = 0; m < 4; ++m) _Pragma("unroll") for (int n = 0; n < 2; ++n) _Pragma("unroll") for (int k = 0; k < 2; ++k) \
        acc[ai][bj][m][n] = __builtin_amdgcn_mfma_f32_16x16x32_bf16(Bt[n][k], At[m][k], acc[ai][bj][m][n], 0, 0, 0); __builtin_amdgcn_s_setprio(0); } while (0)
#define PG8_WAIT_V(n) asm volatile("s_waitcnt vmcnt(" #n ")" ::: "memory")
#define PG8_WAIT_L(n) asm volatile("s_waitcnt lgkmcnt(" #n ")" ::: "memory")
#define PG8_BAR __builtin_amdgcn_s_barrier()
#define PG8_SCHED __builtin_amdgcn_sched_barrier(0)
    Unit cur, nxt; int ui = 0;
    if (!S.next(0, cur)) return;
    f32x4 acc[2][2][4][2];
#pragma unroll
    for (int a = 0; a < 2; ++a)
#pragma unroll
        for (int b = 0; b < 2; ++b)
#pragma unroll
            for (int m = 0; m < 4; ++m)
#pragma unroll
                for (int n = 0; n < 2; ++n) acc[a][b][m][n] = (f32x4){0.f, 0.f, 0.f, 0.f};
    bf16x8 At[4][2], B0[2][2], B1[2][2];
    const char* cA = (const char*)g.A + (size_t)cur.pm * tstep; const char* cB = (const char*)g.Bt + (size_t)cur.pn * tstep;
    S.a_ready(cur);
    if constexpr (SP2) {
        PG8_STAGE(PG8_SB(0, 0), cB, voffB); PG8_STAGE(PG8_SB(0, 1), cB + hstep, voffB); PG8_STAGE(PG8_SA(0, 0), cA, voffA); PG8_STAGE(PG8_SA(0, 1), cA + hstep, voffA);
        if (wr == 1) PG8_BAR;
        PG8_WAIT_V(2); PG8_BAR;
        PG8_STAGE(PG8_SB(1, 0), cB + kstep, voffB); PG8_STAGE(PG8_SA(1, 0), cA + kstep, voffA); PG8_STAGE(PG8_SB(1, 1), cB + hstep + kstep, voffB);
        PG8_WAIT_V(6); PG8_BAR;
    } else {
        PG8_STAGE(PG8_SB(0, 0), cB, voffB); PG8_STAGE(PG8_SA(0, 0), cA, voffA); PG8_STAGE(PG8_SB(0, 1), cB + hstep, voffB); PG8_STAGE(PG8_SA(0, 1), cA + hstep, voffA);
        if (wr == 1) PG8_BAR;
        PG8_WAIT_V(4); PG8_BAR;
        PG8_STAGE(PG8_SB(1, 0), cB + kstep, voffB); PG8_STAGE(PG8_SA(1, 0), cA + kstep, voffA); PG8_STAGE(PG8_SB(1, 1), cB + hstep + kstep, voffB);
        PG8_WAIT_V(6); PG8_BAR;
    }
    for (;;) {
        const bool has_next = S.next(ui + 1, nxt);
        const char* nA = has_next ? (const char*)g.A + (size_t)nxt.pm * tstep : cA; const char* nB = has_next ? (const char*)g.Bt + (size_t)nxt.pn * tstep : cB;
        for (int t = 0; t < nt; t += 2) {
            const bool last = (t == nt - 2);
            const char* a1 = cA + (size_t)(t + 1) * kstep;
            const char* a2 = last ? nA : cA + (size_t)(t + 2) * kstep; const char* b2 = last ? nB : cB + (size_t)(t + 2) * kstep;
            const char* a3 = a2 + kstep; const char* b3 = b2 + kstep;
            if (last && has_next) S.a_ready(nxt);
            if constexpr (SP2) {
            PG8_LDB(B0, 0, 0); PG8_LDB(B1, 0, 1); PG8_SCHED; PG8_LDA(At, 0, 0); PG8_STAGE(PG8_SA(1, 1), a1 + hstep, voffA);
            PG8_WAIT_V(8); PG8_WAIT_L(0); PG8_BAR; PG8_MMA(0, 0, At, B0); PG8_MMA(0, 1, At, B1); PG8_BAR; PG8_SCHED;
            PG8_LDA(At, 0, 1); PG8_STAGE(PG8_SB(0, 0), b2, voffB); PG8_STAGE(PG8_SB(0, 1), b2 + hstep, voffB); PG8_STAGE(PG8_SA(0, 0), a2, voffA);
            PG8_WAIT_V(8); PG8_WAIT_L(0); PG8_BAR; PG8_MMA(1, 0, At, B0); PG8_MMA(1, 1, At, B1); PG8_BAR; PG8_SCHED;
            PG8_LDB(B0, 1, 0); PG8_LDB(B1, 1, 1); PG8_SCHED; PG8_LDA(At, 1, 0); PG8_STAGE(PG8_SA(0, 1), a2 + hstep, voffA);
            PG8_WAIT_V(8); PG8_WAIT_L(0); PG8_BAR; PG8_MMA(0, 0, At, B0); PG8_MMA(0, 1, At, B1); PG8_BAR; PG8_SCHED;
            PG8_LDA(At, 1, 1); PG8_STAGE(PG8_SB(1, 0), b3, voffB); PG8_STAGE(PG8_SB(1, 1), b3 + hstep, voffB); PG8_STAGE(PG8_SA(1, 0), a3, voffA);
            PG8_WAIT_V(8); PG8_WAIT_L(0); PG8_BAR; PG8_MMA(1, 0, At, B0); PG8_MMA(1, 1, At, B1); PG8_BAR; PG8_SCHED;
            } else {
            PG8_LDB(B0, 0, 0); PG8_SCHED; PG8_LDA(At, 0, 0); PG8_STAGE(PG8_SA(1, 1), a1 + hstep, voffA);
            PG8_WAIT_L(8); PG8_BAR; PG8_WAIT_L(0); PG8_MMA(0, 0, At, B0); PG8_BAR; PG8_SCHED;
            PG8_LDB(B1, 0, 1); PG8_STAGE(PG8_SB(0, 0), b2, voffB);
            PG8_BAR; PG8_WAIT_L(0); PG8_MMA(0, 1, At, B1); PG8_BAR;
            PG8_LDA(At, 0, 1); PG8_STAGE(PG8_SA(0, 0), a2, voffA);
            PG8_BAR; PG8_WAIT_L(0); PG8_MMA(1, 0, At, B0); PG8_BAR; PG8_SCHED;
            PG8_STAGE(PG8_SB(0, 1), b2 + hstep, voffB);
            PG8_WAIT_V(6); PG8_BAR; PG8_MMA(1, 1, At, B1); PG8_BAR;
            PG8_LDB(B0, 1, 0); PG8_SCHED; PG8_LDA(At, 1, 0); PG8_STAGE(PG8_SA(0, 1), a2 + hstep, voffA);
            PG8_WAIT_L(8); PG8_BAR; PG8_WAIT_L(0); PG8_MMA(0, 0, At, B0); PG8_BAR; PG8_SCHED;
            PG8_LDB(B1, 1, 1); PG8_STAGE(PG8_SB(1, 0), b3, voffB);
            PG8_BAR; PG8_WAIT_L(0); PG8_MMA(0, 1, At, B1); PG8_BAR;
            PG8_LDA(At, 1, 1); PG8_STAGE(PG8_SA(1, 0), a3, voffA);
            PG8_BAR; PG8_WAIT_L(0); PG8_MMA(1, 0, At, B0); PG8_BAR; PG8_SCHED;
            PG8_STAGE(PG8_SB(1, 1), b3 + hstep, voffB);
            PG8_WAIT_V(6); PG8_BAR; PG8_MMA(1, 1, At, B1); PG8_BAR;
            }
        }
        if constexpr (ALIGN_EPI) { if (wr == 0) PG8_BAR; }
        if constexpr (!Epi::AFTER_DRAIN) { E(acc, cur, wr, wc, fr, fq); S.done(cur); }
        if (!has_next) break;
#pragma unroll
        for (int a = 0; a < 2; ++a)
#pragma unroll
            for (int b = 0; b < 2; ++b)
#pragma unroll
                for (int m = 0; m < 4; ++m)
#pragma unroll
                    for (int n = 0; n < 2; ++n) acc[a][b][m][n] = (f32x4){0.f, 0.f, 0.f, 0.f};
        cur = nxt; cA = nA; cB = nB; ++ui;
        if constexpr (ALIGN_EPI) { if (wr == 1) PG8_BAR; }
    }
    PG8_WAIT_V(0);
    if constexpr (!ALIGN_EPI) { if (wr == 0) PG8_BAR; }
    PG8_BAR;
    if constexpr (Epi::AFTER_DRAIN) { E.fused(acc, cur, wr, wc, fr, fq, lds, wid, lane); S.done(cur); }
#undef PG8_SA
#undef PG8_SB
#undef PG8_STAGE
#undef PG8_LDA
#undef PG8_LDB
#undef PG8_MMA
#undef PG8_WAIT_V
#undef PG8_WAIT_L
#undef PG8_BAR
#undef PG8_SCHED
}
}

constexpr int D = 4096, DFF = 11008, SEQ = 16384, NMETA = 16, LTOT = 16400, MP = 16640;
constexpr int NH = 16, HD = 128, HGW = 2048;
constexpr int QL = 1024, KVL = 512, RD = 64, QKD = 192;
constexpr int INC = 9792, INCP = 9984;
constexpr int ER = 16448;
constexpr int NKT = 257;
constexpr int NCH = 256;
constexpr float EPS = 1e-6f;
constexpr float QSCALE = 0.07216878364870322f * 1.4426950408889634f;
constexpr int NWAVES = 8;

constexpr size_t MiB = 1u << 20;
constexpr size_t al(size_t x) { return (x + MiB - 1) / MiB * MiB; }
constexpr size_t WS_CTL = 0, CTL_ZERO_BYTES = 1 * MiB;
constexpr size_t WS_LB = 1 * MiB;
constexpr size_t WS_G1 = WS_LB + 16384, WS_G2 = WS_LB + 32768;
constexpr size_t WS_COS = WS_LB + 65536, WS_SIN = WS_COS + al((size_t)LTOT * 32 * 4);
constexpr size_t WS_W1GU = WS_SIN + al((size_t)LTOT * 32 * 4);
constexpr size_t WS_W1D = WS_W1GU + al((size_t)2 * DFF * D * 2);
constexpr size_t WS_W2GU = WS_W1D + al((size_t)D * DFF * 2);
constexpr size_t WS_W2D = WS_W2GU + al((size_t)2 * DFF * D * 2);
constexpr size_t WS_WIN = WS_W2D + al((size_t)D * DFF * 2);
constexpr size_t WS_WUQ = WS_WIN + al((size_t)INCP * D * 2);
constexpr size_t WS_WUKV = WS_WUQ + al((size_t)3072 * QL * 2);
constexpr size_t WS_WOUT = WS_WUKV + al((size_t)4096 * KVL * 2);
constexpr size_t WS_HM = WS_WOUT + al((size_t)D * D * 2);
constexpr size_t WS_ARENA = WS_HM + al((size_t)256 * D * 4);
constexpr size_t AR_ACT = WS_ARENA;
constexpr size_t AR_XN = AR_ACT + al((size_t)MP * DFF * 2);
constexpr size_t AR_EXTRA = AR_XN + al((size_t)MP * D * 2);
constexpr size_t AR_HQ = AR_ACT;
constexpr size_t AR_LOGF = AR_HQ + al((size_t)ER * HGW * 2);
constexpr size_t AR_HV = AR_LOGF + al((size_t)ER * HGW * 4);
constexpr size_t AR_G = AR_HV + al((size_t)ER * HGW * 2);
constexpr size_t AR_G_END = AR_G + al((size_t)MP * HGW * 2);
static_assert(AR_G_END <= AR_XN, "P4 outputs must not touch XN");
constexpr size_t AR_MIXED = AR_XN;
constexpr size_t AR_CQ = AR_EXTRA;
constexpr size_t AR_CKV = AR_CQ + al((size_t)MP * QL * 2);
constexpr size_t AR_KR = AR_CKV + al((size_t)MP * KVL * 2);
constexpr size_t AR_CQN = AR_KR + al((size_t)MP * RD * 2);
constexpr size_t AR_CKVN = AR_CQN + al((size_t)MP * QL * 2);
constexpr size_t AR_SU = AR_CKVN + al((size_t)MP * KVL * 2);
constexpr size_t AR_AC = AR_SU + al((size_t)NCH * NH * HD * HD * 2);
constexpr size_t AR_AC_END = AR_AC + al((size_t)NCH * NH * HD * 4);
constexpr size_t AR_QRAW = AR_ACT;
constexpr size_t AR_KVRAW = AR_QRAW + al((size_t)SEQ * 3072 * 2);
constexpr size_t AR_QH = AR_KVRAW + al((size_t)MP * 4096 * 2);
constexpr size_t AR_QH_END = AR_QH + al((size_t)NH * SEQ * QKD * 2);
static_assert(AR_QH_END <= AR_XN, "QH inside the ACT area");
constexpr size_t AR_XN2 = AR_EXTRA;
constexpr size_t AR_KH = AR_SU;
constexpr size_t AR_VT = AR_KH + al((size_t)NH * NKT * 24576);
constexpr size_t AR_VT_END = AR_VT + al((size_t)NH * NKT * 16384);
constexpr size_t WS_END = (AR_VT_END > AR_AC_END ? AR_VT_END : AR_AC_END);
static_assert(AR_XN2 + (size_t)SEQ * D * 2 <= WS_END, "XN2 inside the extra area");

constexpr int CW_BAR = 4096;
constexpr size_t CTL_STAT1 = 65536, CTL_STAT2 = 65536 + 131072;

constexpr int RING_OFF = 0, RING_BYTES = 131072;
constexpr int LDSCTL_OFF = RING_BYTES, MISC_OFF = LDSCTL_OFF + 320;
constexpr int LDS_BYTES = 147456;

#define LAS __attribute__((address_space(3)))
typedef unsigned short bf16;
typedef unsigned v4u __attribute__((ext_vector_type(4)));
typedef unsigned v2u __attribute__((ext_vector_type(2)));
typedef float f32x4 __attribute__((ext_vector_type(4)));
typedef float f32x2 __attribute__((ext_vector_type(2)));
typedef float f32x16 __attribute__((ext_vector_type(16)));
typedef short bf16x8 __attribute__((ext_vector_type(8)));
#define LDS_WAIT() asm volatile("s_waitcnt lgkmcnt(0)" ::: "memory")
#define VM_WAIT() asm volatile("s_waitcnt vmcnt(0)" ::: "memory")
#define MFMA32(a, b, c) __builtin_amdgcn_mfma_f32_32x32x16_bf16((a), (b), (c), 0, 0, 0)
using pg8::pk_bf16;
__device__ __forceinline__ float bf2f(unsigned short b) { return __uint_as_float(((unsigned)b) << 16); }
__device__ __forceinline__ float bflo(unsigned w) { return __uint_as_float(w << 16); }
__device__ __forceinline__ float bfhi(unsigned w) { return __uint_as_float(w & 0xffff0000u); }
__device__ __forceinline__ unsigned short f2bf(float f) { return (unsigned short)(pk_bf16(f, 0.f) & 0xffffu); }
__device__ __forceinline__ float wave_sum(float v) {
#pragma unroll
    for (int o = 1; o < 64; o <<= 1) v += __shfl_xor(v, o);
    return v;
}
__device__ __forceinline__ int crow(int reg, int h) { return (reg & 3) + 8 * (reg >> 2) + 4 * h; }
__device__ __forceinline__ bf16x8 pack8(const f32x16& x, int s) {
    v4u p; p.x = pk_bf16(x[8 * s], x[8 * s + 1]); p.y = pk_bf16(x[8 * s + 2], x[8 * s + 3]); p.z = pk_bf16(x[8 * s + 4], x[8 * s + 5]); p.w = pk_bf16(x[8 * s + 6], x[8 * s + 7]);
    return __builtin_bit_cast(bf16x8, p);
}
#define XB_TMO      128
#define XB_XCNT(j)  (256  + 64 * (j))
#define XB_XSUB(j)  (1280 + 64 * (j))
#define XB_XGEN(j)  (2304 + 64 * (j))
#define XB_TOP      3328
#define XB_TOPGEN   3392
#define XCD_BAR_WORDS 3456
#define XB_SPIN_CAP (1u << 18)

__device__ __forceinline__ unsigned xb_ld(unsigned* p)              { return __hip_atomic_load(p, __ATOMIC_RELAXED, __HIP_MEMORY_SCOPE_AGENT); }
__device__ __forceinline__ unsigned xb_add(unsigned* p, unsigned v) { return __hip_atomic_fetch_add(p, v, __ATOMIC_RELAXED, __HIP_MEMORY_SCOPE_AGENT); }
__device__ __forceinline__ unsigned xb_xcc_id() { return (unsigned)__builtin_amdgcn_s_getreg((3 << 11) | 20) & 0xFu; }
#define XB_SPIN(cond, bar) do { unsigned _sp = 0; while (cond) { __builtin_amdgcn_s_sleep(1); \
    if ((++_sp & 255u) == 0u) { if (xb_ld(&(bar)[XB_TMO])) break; if (_sp > XB_SPIN_CAP) { atomicAdd(&(bar)[XB_TMO], 1u); break; } } } } while (0)

struct XcdBarrier {
    unsigned* bar; unsigned x;
    volatile LAS unsigned* st;
};

__device__ __forceinline__ XcdBarrier xcd_barrier_post(unsigned* bar, volatile LAS unsigned* st) {
    XcdBarrier b; b.bar = bar; b.x = xb_xcc_id(); b.st = st;
    if (threadIdx.x == 0) (void)xb_add(&bar[XB_XCNT(b.x)], 1u);
    return b;
}
__device__ __forceinline__ void xcd_barrier_complete(unsigned* bar, unsigned x, unsigned& nloc, unsigned& nx) {
    const unsigned G = gridDim.x * gridDim.y * gridDim.z;
    unsigned sum, cnt, mine, sp = 0u;
    for (;;) {
        sum = 0u; cnt = 0u; mine = 0u;
#pragma unroll
        for (unsigned j = 0; j < 16; ++j) { const unsigned c = xb_ld(&bar[XB_XCNT(j)]); sum += c; cnt += (c > 0u) ? 1u : 0u; mine = (j == x) ? c : mine; }
        if (sum == G) break;
        __builtin_amdgcn_s_sleep(1);
        if ((++sp & 255u) == 0u) { if (xb_ld(&bar[XB_TMO])) break; if (sp > XB_SPIN_CAP) { atomicAdd(&bar[XB_TMO], 1u); break; } }
    }
    nloc = mine > 0u ? mine : 1u; nx = cnt > 0u ? cnt : 1u;
}

__device__ __forceinline__ void xcd_barrier(const XcdBarrier& b) {
    asm volatile("s_waitcnt vmcnt(0)" ::: "memory");
    __syncthreads();
    if (threadIdx.x == 0) {
        unsigned* bar = b.bar;
        __builtin_amdgcn_s_waitcnt(0);
        unsigned nloc = b.st[0], nx = b.st[1];
        if (nloc == 0u) { xcd_barrier_complete(bar, b.x, nloc, nx); b.st[0] = nloc; b.st[1] = nx; }
        const unsigned old = xb_add(&bar[XB_XSUB(b.x)], 1u);
        const unsigned gen = old / nloc;
        if (old + 1u == (gen + 1u) * nloc) {
            __builtin_amdgcn_fence(__ATOMIC_RELEASE, "agent");
            asm volatile("s_waitcnt vmcnt(0)" ::: "memory");
            const unsigned og = xb_add(&bar[XB_TOP], 1u);
            const unsigned tg = og / nx;
            if (og + 1u == (tg + 1u) * nx) xb_add(&bar[XB_TOPGEN], 1u);
            else XB_SPIN(xb_ld(&bar[XB_TOPGEN]) == tg, bar);
            __builtin_amdgcn_fence(__ATOMIC_ACQUIRE, "agent");
            xb_add(&bar[XB_XGEN(b.x)], 1u);
            asm volatile("s_waitcnt vmcnt(0)" ::: "memory");
        } else {
            XB_SPIN(xb_ld(&bar[XB_XGEN(b.x)]) == gen, bar);
            __builtin_amdgcn_fence(__ATOMIC_ACQUIRE, "agent");
            asm volatile("s_waitcnt vmcnt(0)" ::: "memory");
        }
    }
    __syncthreads();
}

struct Args { const float* in[22]; float* out; unsigned char* ws; int ph_lo, ph_hi; };
struct Frame {
    LAS unsigned char* lds;
    int tid, lane, wave, G, vcu;
    unsigned char* ws; float* out;
};

struct TItem { const float* W; bf16* WT; int K, N, k0, n0, drow0; };
__device__ __forceinline__ void titem_load(const TItem& t, float (&v)[32], int lane) {
    const float* p = t.W + (size_t)(t.k0 + (lane >> 5)) * t.N + t.n0 + (lane & 31);
#pragma unroll
    for (int i = 0; i < 32; ++i) v[i] = __builtin_nontemporal_load(p + (size_t)(2 * i) * t.N);
}
__device__ __forceinline__ void titem_store(const TItem& t, const float (&v)[32], LAS float* scr, int lane) {
#pragma unroll
    for (int i = 0; i < 32; ++i) scr[(2 * i + (lane >> 5)) * 33 + (lane & 31)] = v[i];
    LDS_WAIT(); asm volatile("" ::: "memory");
    const int c = lane & 7;
#pragma unroll
    for (int j = 0; j < 4; ++j) { const int n = (lane >> 3) + 8 * j; const LAS float* s = scr + (8 * c) * 33 + n;
        v4u o; o.x = pk_bf16(s[0 * 33], s[1 * 33]); o.y = pk_bf16(s[2 * 33], s[3 * 33]); o.z = pk_bf16(s[4 * 33], s[5 * 33]); o.w = pk_bf16(s[6 * 33], s[7 * 33]);
        *(v4u*)(t.WT + (size_t)(t.drow0 + n) * t.K + t.k0 + 8 * c) = o; }
    LDS_WAIT(); asm volatile("" ::: "memory");
}
__device__ __forceinline__ void rms_row_to_bf16(const float* xrow, const float* w, bf16* orow, int lane) {
    const f32x4* xr = (const f32x4*)xrow + lane; const f32x4* wr = (const f32x4*)w + lane;
    f32x4 v[16]; float s = 0.f;
#pragma unroll
    for (int j = 0; j < 16; ++j) { v[j] = xr[64 * j]; s += (v[j].x * v[j].x + v[j].y * v[j].y) + (v[j].z * v[j].z + v[j].w * v[j].w); }
    const float rstd = 1.0f / sqrtf(wave_sum(s) * (1.0f / D) + EPS);
    v2u* o8 = (v2u*)orow + lane;
#pragma unroll
    for (int j = 0; j < 16; ++j) { const f32x4 g = wr[64 * j]; v2u o; o.x = pk_bf16(v[j].x * rstd * g.x, v[j].y * rstd * g.y); o.y = pk_bf16(v[j].z * rstd * g.z, v[j].w * rstd * g.w); o8[64 * j] = o; }
}
__device__ __forceinline__ void norm_phase(const Frame& F, const float* lo, const float* hi, const float* w, bf16* XN, int nrows, int nzero_to) {
    const int gw = F.vcu * NWAVES + F.wave, NGW = F.G * NWAVES;
    for (int r = gw; r < nrows; r += NGW) rms_row_to_bf16(r < SEQ ? lo + (size_t)r * D : hi + (size_t)(r - SEQ) * D, w, XN + (size_t)r * D, F.lane);
    for (int r = nrows + gw; r < nzero_to; r += NGW) { v4u* o = (v4u*)(XN + (size_t)r * D) + F.lane;
#pragma unroll
        for (int j = 0; j < 8; ++j) o[64 * j] = (v4u){0u, 0u, 0u, 0u}; }
}
__device__ const float ROPE_INVF[32] = {1.000000000e+00f, 7.498942018e-01f, 5.623413324e-01f, 4.216965139e-01f, 3.162277639e-01f, 2.371373922e-01f, 1.778279394e-01f, 1.333521456e-01f, 1.000000015e-01f, 7.498941571e-02f, 5.623412877e-02f, 4.216964915e-02f, 3.162277862e-02f, 2.371373586e-02f, 1.778279431e-02f, 1.333521493e-02f, 9.999999776e-03f, 7.498942316e-03f, 5.623413250e-03f, 4.216964822e-03f, 3.162277862e-03f, 2.371373819e-03f, 1.778279431e-03f, 1.333521446e-03f, 1.000000047e-03f, 7.498941850e-04f, 5.623413017e-04f, 4.216965463e-04f, 3.162277862e-04f, 2.371373848e-04f, 1.778279402e-04f, 1.333521504e-04f};
__device__ __forceinline__ void sincos_d(double a, float& c, float& s) {
    const double TWO_OVER_PI = 0.63661977236758134308, PIO2_HI = 1.57079632673412561417, PIO2_LO = 6.07710050650619224932e-11;
    const double q = __builtin_rint(a * TWO_OVER_PI); const double r = (a - q * PIO2_HI) - q * PIO2_LO; const int qi = (int)q & 3;
    const double r2 = r * r;
    const double sp = r * (1.0 + r2 * (-1.0 / 6 + r2 * (1.0 / 120 + r2 * (-1.0 / 5040 + r2 * (1.0 / 362880 + r2 * (-1.0 / 39916800 + r2 * (1.0 / 6227020800.0)))))));
    const double cp = 1.0 + r2 * (-0.5 + r2 * (1.0 / 24 + r2 * (-1.0 / 720 + r2 * (1.0 / 40320 + r2 * (-1.0 / 3628800 + r2 * (1.0 / 479001600.0 + r2 * (-1.0 / 87178291200.0)))))));
    const double sv = (qi == 0) ? sp : (qi == 1) ? cp : (qi == 2) ? -sp : -cp;
    const double cv = (qi == 0) ? cp : (qi == 1) ? -sp : (qi == 2) ? -cp : sp;
    c = (float)cv; s = (float)sv;
}
constexpr int KB_D = D / 64, KB_F = DFF / 64;
constexpr long I_GU = (long)KB_D * (DFF / 32), I_DN = (long)KB_F * (D / 32);
constexpr long I_IN = (long)KB_D * (INC / 32), I_UQ = (long)(QL / 64) * (3072 / 32), I_UKV = (long)(KVL / 64) * (4096 / 32), I_OUT = (long)KB_D * (D / 32);
constexpr long NITEMS = 4 * I_GU + 2 * I_DN + I_IN + I_UQ + I_UKV + I_OUT;
__device__ __forceinline__ void titem_decode(const Args& A, unsigned char* ws, long r, TItem& t) {
        if (r < 4 * I_GU) {
            const int which = (int)(r / I_GU); const int q = (int)(r % I_GU); const int nb = q % (DFF / 32), kb = q / (DFF / 32), n0 = nb * 32;
            const float* w4 = A.in[4]; const float* w5 = A.in[5]; const float* w18 = A.in[18]; const float* w19 = A.in[19]; t.W = which == 0 ? w4 : which == 1 ? w5 : which == 2 ? w18 : w19;     t.WT = (bf16*)(ws + (which < 2 ? WS_W1GU : WS_W2GU)); t.K = D; t.N = DFF; t.k0 = kb * 64; t.n0 = n0;
            t.drow0 = 256 * (n0 >> 7) + (n0 & 127) + ((which & 1) ? 128 : 0); return; }
        r -= 4 * I_GU;
        if (r < 2 * I_DN) { const int which = (int)(r / I_DN); const int q = (int)(r % I_DN); const int nb = q % (D / 32), kb = q / (D / 32);
            const float* w20 = A.in[20]; const float* w6 = A.in[6]; t.W = which ? w20 : w6; t.WT = (bf16*)(ws + (which ? WS_W2D : WS_W1D)); t.K = DFF; t.N = D; t.k0 = kb * 64; t.n0 = nb * 32; t.drow0 = nb * 32; return; }
        r -= 2 * I_DN;
        if (r < I_IN) { const int q = (int)r; const int nb = q % (INC / 32), kb = q / (INC / 32); t.W = A.in[8]; t.WT = (bf16*)(ws + WS_WIN); t.K = D; t.N = INC; t.k0 = kb * 64; t.n0 = nb * 32; t.drow0 = nb * 32; return; }
        r -= I_IN;
        if (r < I_UQ) { const int q = (int)r; const int nb = q % (3072 / 32), kb = q / (3072 / 32); t.W = A.in[11]; t.WT = (bf16*)(ws + WS_WUQ); t.K = QL; t.N = 3072; t.k0 = kb * 64; t.n0 = nb * 32; t.drow0 = nb * 32; return; }
        r -= I_UQ;
        if (r < I_UKV) { const int q = (int)r; const int nb = q % (4096 / 32), kb = q / (4096 / 32); t.W = A.in[13]; t.WT = (bf16*)(ws + WS_WUKV); t.K = KVL; t.N = 4096; t.k0 = kb * 64; t.n0 = nb * 32; t.drow0 = nb * 32; return; }
        r -= I_UKV;
        { const int q = (int)r; const int nb = q % (D / 32), kb = q / (D / 32); t.W = A.in[16]; t.WT = (bf16*)(ws + WS_WOUT); t.K = D; t.N = D; t.k0 = kb * 64; t.n0 = nb * 32; t.drow0 = nb * 32; }
}
__device__ __forceinline__ void p0_prologue(const Frame& F, const Args& A) {
    unsigned char* ws = F.ws;
    LAS float* scr = (LAS float*)(F.lds + RING_OFF + F.wave * 16384);
    const int gw = F.vcu * NWAVES + F.wave, NGW = F.G * NWAVES;
    if (gw < NITEMS) {
        TItem cur, nxt; float va[32], vb[32];
        titem_decode(A, ws, gw, cur); titem_load(cur, va, F.lane);
        for (long it = gw; it < NITEMS; it += 2 * NGW) {
            const bool h1 = it + NGW < NITEMS; if (h1) { titem_decode(A, ws, it + NGW, nxt); titem_load(nxt, vb, F.lane); }
            titem_store(cur, va, scr, F.lane);
            if (!h1) break;
            const bool h2 = it + 2 * NGW < NITEMS; if (h2) { titem_decode(A, ws, it + 2 * NGW, cur); titem_load(cur, va, F.lane); }
            titem_store(nxt, vb, scr, F.lane);
            if (!h2) break;
        }
    }
    { v4u* z = (v4u*)(ws + WS_WIN + (size_t)INC * D * 2); const size_t n16 = (size_t)(INCP - INC) * D * 2 / 16;
      for (size_t i = (size_t)F.vcu * 512 + F.tid; i < n16; i += (size_t)F.G * 512) z[i] = (v4u){0u, 0u, 0u, 0u}; }
    { float* HM = (float*)(ws + WS_HM); const float* meta = A.in[1];
      for (int i = F.vcu * 512 + F.tid; i < 256 * D; i += F.G * 512) HM[i] = (i < NMETA * D) ? meta[i] : 0.f; }
    norm_phase(F, A.in[0], A.in[1], A.in[3], (bf16*)(ws + AR_XN), LTOT, MP);
    { float* g1 = (float*)(ws + WS_G1); float* g2 = (float*)(ws + WS_G2); for (int i = F.vcu * 512 + F.tid; i < D; i += F.G * 512) { g1[i] = A.in[7][i]; g2[i] = A.in[17][i]; } }
    { float* lb = (float*)(ws + WS_LB); const float* lp = A.in[2];
      for (int i = F.vcu * 512 + F.tid; i < HGW; i += F.G * 512) { const float a = lp[i], b = lp[HGW + i], m = fmaxf(a, b); const float ea = expf(a - m), eb = expf(b - m); lb[i] = ea / (ea + eb); } }
    { float* ct = (float*)(ws + WS_COS); float* st = (float*)(ws + WS_SIN);
      for (int i = F.vcu * 512 + F.tid; i < LTOT * 32; i += F.G * 512) { const int pos = i >> 5, k = i & 31;
          const float invf = ROPE_INVF[k];
          const float ang = (float)pos * invf; float c, s; sincos_d((double)ang, c, s); ct[i] = c; st[i] = s; } }
}
__device__ __forceinline__ void zero_null_rows(const Frame& F) {
    float* LOGF = (float*)(F.ws + AR_LOGF); unsigned* HVw = (unsigned*)(F.ws + AR_HV);
    for (int i = F.vcu * 512 + F.tid; i < 48 * HGW; i += F.G * 512) { LOGF[i] = 0.f; if (i < 48 * HGW / 2) HVw[i] = 0u; }
}
__device__ __forceinline__ void final_norm(const Frame& F, const float* w) {
    const int gw = F.vcu * NWAVES + F.wave, NGW = F.G * NWAVES;
    int lane = F.lane; asm volatile("" : "+v"(lane));
    for (int r = gw; r < SEQ; r += NGW) {
        f32x4* xr = (f32x4*)(F.out + (size_t)r * D) + lane; const f32x4* wr = (const f32x4*)w + lane;
        f32x4 v[16]; float s = 0.f;
#pragma unroll
        for (int j = 0; j < 16; ++j) { v[j] = xr[64 * j]; s += (v[j].x * v[j].x + v[j].y * v[j].y) + (v[j].z * v[j].z + v[j].w * v[j].w); }
        const float rstd = 1.0f / sqrtf(wave_sum(s) * (1.0f / D) + EPS);
#pragma unroll
        for (int j = 0; j < 16; ++j) { const f32x4 g = wr[64 * j]; xr[64 * j] = v[j] * rstd * g; }
    }
}

__device__ __forceinline__ void meta_down_phase(const Frame& F, const bf16* ACT, const bf16* WT, float* HM, float scale, bf16* XB, float* stat, const float* gain) {
    typedef float f32x4_ __attribute__((ext_vector_type(4)));
    LAS float* red = (LAS float*)(F.lds + RING_OFF);
    const int i = F.lane & 15, kq = F.lane >> 4;
    for (int cb = F.vcu; cb < D / 16; cb += F.G) {
        const bf16* ap = ACT + (size_t)(SEQ + i) * DFF + F.wave * 1376 + 8 * kq;
        const bf16* bp = WT + (size_t)(16 * cb + i) * DFF + F.wave * 1376 + 8 * kq;
        f32x4_ acc = {0.f, 0.f, 0.f, 0.f};
#pragma unroll 8
        for (int s = 0; s < 43; ++s) { const bf16x8 a = *(const bf16x8*)(ap + 32 * s); const bf16x8 b = *(const bf16x8*)(bp + 32 * s); acc = __builtin_amdgcn_mfma_f32_16x16x32_bf16(a, b, acc, 0, 0, 0); }
#pragma unroll
        for (int j = 0; j < 4; ++j) red[F.wave * 256 + (4 * kq + j) * 16 + i] = acc[j];
        __syncthreads();
        if (F.tid < 256) { float s = 0.f;
#pragma unroll
            for (int w = 0; w < 8; ++w) s += red[w * 256 + F.tid];
            const int row = F.tid >> 4, col = 16 * cb + (F.tid & 15); const float v = HM[(size_t)row * D + col] + scale * s; HM[(size_t)row * D + col] = v;
            XB[(size_t)(SEQ + row) * D + col] = f2bf(v * gain[col]); float q = v * v; q += __shfl_xor(q, 1); q += __shfl_xor(q, 2); q += __shfl_xor(q, 4); q += __shfl_xor(q, 8); if ((F.tid & 15) == 0) atomicAdd(stat + SEQ + row, q); }
        __syncthreads();
    }
}
template <int N>
__device__ __forceinline__ void lat_norm(const Frame& F, const bf16* src, const float* w, bf16* dst, int nvalid, int ntotal) {
    constexpr int PER = N / 64;
    const int gw = F.vcu * NWAVES + F.wave, NGW = F.G * NWAVES;
    for (int r = gw; r < ntotal; r += NGW) {
        unsigned xw[PER / 2]; float x[PER]; float s = 0.f;
        if (r < nvalid) {
#pragma unroll
            for (int j = 0; j < PER / 8; ++j) { const v4u t = *((const v4u*)(src + (size_t)r * N + F.lane * PER) + j); xw[4 * j] = t.x; xw[4 * j + 1] = t.y; xw[4 * j + 2] = t.z; xw[4 * j + 3] = t.w; }
#pragma unroll
            for (int j = 0; j < PER / 2; ++j) { x[2 * j] = bflo(xw[j]); x[2 * j + 1] = bfhi(xw[j]); s += x[2 * j] * x[2 * j] + x[2 * j + 1] * x[2 * j + 1]; }
            const float rstd = 1.0f / sqrtf(wave_sum(s) * (1.0f / N) + EPS);
#pragma unroll
            for (int j = 0; j < PER / 8; ++j) { const f32x4 g0 = *(const f32x4*)(w + F.lane * PER + 8 * j), g1 = *(const f32x4*)(w + F.lane * PER + 8 * j + 4);
                v4u o; o.x = pk_bf16(x[8 * j] * rstd * g0.x, x[8 * j + 1] * rstd * g0.y); o.y = pk_bf16(x[8 * j + 2] * rstd * g0.z, x[8 * j + 3] * rstd * g0.w);
                o.z = pk_bf16(x[8 * j + 4] * rstd * g1.x, x[8 * j + 5] * rstd * g1.y); o.w = pk_bf16(x[8 * j + 6] * rstd * g1.z, x[8 * j + 7] * rstd * g1.w);
                *((v4u*)(dst + (size_t)r * N + F.lane * PER) + j) = o; }
        } else {
#pragma unroll
            for (int j = 0; j < PER / 8; ++j) *((v4u*)(dst + (size_t)r * N + F.lane * PER) + j) = (v4u){0u, 0u, 0u, 0u};
        }
    }
}

__device__ __forceinline__ void hgrn_cumsum8(const f32x2 (&g)[8], f32x2 (&c)[8]) { c[0] = g[0];
#pragma unroll
    for (int i = 1; i < 8; ++i) c[i] = c[i - 1] + g[i]; }

__device__ __forceinline__ void hgrn_pass_a(const Frame& F) {
    const float* LOGF = (const float*)(F.ws + AR_LOGF); const unsigned* HVw = (const unsigned*)(F.ws + AR_HV);
    bf16* SU = (bf16*)(F.ws + AR_SU); float* AC = (float*)(F.ws + AR_AC);
    LAS unsigned char* KDT = F.lds + RING_OFF; LAS unsigned char* VTT = F.lds + RING_OFF + 16384; LAS float* SEGT = (LAS float*)(F.lds + RING_OFF + 32768);
    const int c2 = F.lane, seg = F.wave, hh = F.lane >> 5, l31 = F.lane & 31;
    f32x2 gn[8]; unsigned vn[8];
#define HA_FETCH(it_) do { const int cc_ = (it_) >> 4, h_ = (it_) & 15; _Pragma("unroll") for (int i = 0; i < 8; ++i) { const size_t row = (size_t)(64 * cc_ + 8 * seg + i); \
        gn[i] = *(const f32x2*)(LOGF + row * HGW + h_ * HD + 2 * c2); vn[i] = HVw[(row * HGW + h_ * HD + 2 * c2) >> 1]; } } while (0)
    if (F.vcu < NCH * NH) HA_FETCH(F.vcu);
    for (int item = F.vcu; item < NCH * NH; item += F.G) {
        const int cc = item >> 4, h = item & 15;
        f32x2 g[8], c[8]; unsigned vw[8];
#pragma unroll
        for (int i = 0; i < 8; ++i) { g[i] = gn[i]; vw[i] = vn[i]; }
        if (item + F.G < NCH * NH) HA_FETCH(item + F.G);
        hgrn_cumsum8(g, c);
        *(LAS f32x2*)(SEGT + seg * 128 + 2 * c2) = c[7];
        __syncthreads();
        f32x2 off = {0.f, 0.f}, tot = {0.f, 0.f};
#pragma unroll
        for (int s = 0; s < 8; ++s) { const f32x2 t = *(const LAS f32x2*)(SEGT + s * 128 + 2 * c2); tot += t; if (s < seg) off += t; }
        float k0[8], k1[8];
#pragma unroll
        for (int i = 0; i < 8; ++i) { const f32x2 b = off + c[i];
            k0[i] = (1.0f - __expf(g[i].x)) * __expf(tot.x - b.x); k1[i] = (1.0f - __expf(g[i].y)) * __expf(tot.y - b.y); }
        const int sw = ((seg ^ (c2 & 7)) << 4);
        { v4u p; p.x = pk_bf16(k0[0], k0[1]); p.y = pk_bf16(k0[2], k0[3]); p.z = pk_bf16(k0[4], k0[5]); p.w = pk_bf16(k0[6], k0[7]); *(LAS v4u*)(KDT + (2 * c2) * 128 + sw) = p;
          v4u q; q.x = pk_bf16(k1[0], k1[1]); q.y = pk_bf16(k1[2], k1[3]); q.z = pk_bf16(k1[4], k1[5]); q.w = pk_bf16(k1[6], k1[7]); *(LAS v4u*)(KDT + (2 * c2 + 1) * 128 + sw) = q; }
        { v4u p, q;
          p.x = (vw[0] & 0xffffu) | (vw[1] << 16); p.y = (vw[2] & 0xffffu) | (vw[3] << 16); p.z = (vw[4] & 0xffffu) | (vw[5] << 16); p.w = (vw[6] & 0xffffu) | (vw[7] << 16);
          q.x = (vw[0] >> 16) | (vw[1] & 0xffff0000u); q.y = (vw[2] >> 16) | (vw[3] & 0xffff0000u); q.z = (vw[4] >> 16) | (vw[5] & 0xffff0000u); q.w = (vw[6] >> 16) | (vw[7] & 0xffff0000u);
          *(LAS v4u*)(VTT + (2 * c2) * 128 + sw) = p; *(LAS v4u*)(VTT + (2 * c2 + 1) * 128 + sw) = q; }
        if (seg == 7) { f32x2 a; a.x = __expf(tot.x); a.y = __expf(tot.y); *(f32x2*)(AC + (size_t)item * HD + 2 * c2) = a; }
        __syncthreads();
        const int dvb = F.wave & 3, dkb0 = 2 * (F.wave >> 2);
        bf16x8 vf[4];
        { const int dv = dvb * 32 + l31;
#pragma unroll
          for (int ks = 0; ks < 4; ++ks) vf[ks] = *(const LAS bf16x8*)(VTT + dv * 128 + (((2 * ks + hh) ^ ((dv >> 1) & 7)) << 4)); }
#pragma unroll
        for (int q = 0; q < 2; ++q) {
            const int dk = (dkb0 + q) * 32 + l31; f32x16 acc;
#pragma unroll
            for (int i = 0; i < 16; ++i) acc[i] = 0.f;
#pragma unroll
            for (int ks = 0; ks < 4; ++ks) { const bf16x8 kf = *(const LAS bf16x8*)(KDT + dk * 128 + (((2 * ks + hh) ^ ((dk >> 1) & 7)) << 4)); acc = MFMA32(kf, vf[ks], acc); }
            bf16* dst = SU + (size_t)item * (HD * HD) + (size_t)(dvb * 32 + l31) * HD + (dkb0 + q) * 32 + 4 * hh;
#pragma unroll
            for (int g4 = 0; g4 < 4; ++g4) { v2u o; o.x = pk_bf16(acc[4 * g4], acc[4 * g4 + 1]); o.y = pk_bf16(acc[4 * g4 + 2], acc[4 * g4 + 3]); *(v2u*)(dst + 8 * g4) = o; }
        }
    }
    __syncthreads();
#undef HA_FETCH
}

__device__ __forceinline__ void hgrn_pass_b(const Frame& F) {
    unsigned* SUw = (unsigned*)(F.ws + AR_SU); const float* AC = (const float*)(F.ws + AR_AC);
    constexpr int NB = 16;
    for (int gt = F.vcu * 512 + F.tid; gt < NH * HD * (HD / 2); gt += F.G * 512) {
        const int h = gt >> 13, rem = gt & 8191, dkp = rem & 63;
        unsigned* up = SUw + (size_t)h * (HD * HD / 2) + rem; const float* ap = AC + (size_t)h * HD + 2 * dkp;
        f32x2 S = {0.f, 0.f};
        unsigned ua[NB], ub[NB]; f32x2 aa[NB], ab[NB];
#define HB_LOAD(u_, a_, c0_) do { _Pragma("unroll") for (int j = 0; j < NB; ++j) { u_[j] = up[(size_t)((c0_) + j) * (NH * HD * HD / 2)]; a_[j] = *(const f32x2*)(ap + (size_t)((c0_) + j) * (NH * HD)); } } while (0)
#define HB_STEP(u_, a_, c0_) do { unsigned o_[NB]; _Pragma("unroll") for (int j = 0; j < NB; ++j) { S.x = a_[j].x * S.x + bflo(u_[j]); S.y = a_[j].y * S.y + bfhi(u_[j]); o_[j] = pk_bf16(S.x, S.y); } \
        _Pragma("unroll") for (int j = 0; j < NB; ++j) up[(size_t)((c0_) + j) * (NH * HD * HD / 2)] = o_[j]; } while (0)
        HB_LOAD(ua, aa, 0);
#pragma unroll 1
        for (int c0 = 0; c0 < NCH; c0 += 2 * NB) {
            HB_LOAD(ub, ab, c0 + NB);
            HB_STEP(ua, aa, c0);
            if (c0 + 2 * NB < NCH) HB_LOAD(ua, aa, c0 + 2 * NB);
            HB_STEP(ub, ab, c0 + NB);
        }
#undef HB_LOAD
#undef HB_STEP
    }
}

__device__ __forceinline__ void hgrn_pass_c(const Frame& F, const float* hg_norm) {
    const float* LOGF = (const float*)(F.ws + AR_LOGF); const unsigned* HVw = (const unsigned*)(F.ws + AR_HV); const unsigned* HQw = (const unsigned*)(F.ws + AR_HQ);
    const bf16* SU = (const bf16*)(F.ws + AR_SU); const bf16* G = (const bf16*)(F.ws + AR_G); bf16* MIXED = (bf16*)(F.ws + AR_MIXED);
    LAS unsigned char* QT = F.lds + RING_OFF; LAS unsigned char* QHh = F.lds + RING_OFF + 16384; LAS unsigned char* KT = F.lds + RING_OFF + 32768; LAS unsigned char* VTP = F.lds + RING_OFF + 49152;
    LAS float* SEGT = (LAS float*)(F.lds + RING_OFF + 65536); LAS float* SS = (LAS float*)(F.lds + RING_OFF + 69632);
    const int c2 = F.lane, seg = F.wave, hh = F.lane >> 5, l31 = F.lane & 31;
    f32x2 gn[8]; unsigned vn[8], qn[8];
#define HC_FETCH(it_) do { const int cc_ = ((it_) >> 4) + 1, h_ = (it_) & 15; _Pragma("unroll") for (int i = 0; i < 8; ++i) { const size_t idx = (size_t)(64 * cc_ + 8 * seg + i) * HGW + h_ * HD + 2 * c2; \
        gn[i] = *(const f32x2*)(LOGF + idx); vn[i] = HVw[idx >> 1]; qn[i] = HQw[idx >> 1]; } } while (0)
    if (F.vcu < NCH * NH) HC_FETCH(F.vcu);
    for (int item = F.vcu; item < NCH * NH; item += F.G) {
        const int cc = (item >> 4) + 1, h = item & 15;
        f32x2 g[8], c[8]; unsigned vw[8], qw[8];
#pragma unroll
        for (int i = 0; i < 8; ++i) { g[i] = gn[i]; vw[i] = vn[i]; qw[i] = qn[i]; }
        const int dvb = F.wave & 3, tb = F.wave >> 2;
        const int trow = 32 * tb + l31, dv = dvb * 32 + l31;
        bf16x8 sfr[8]; v2u gtv[4]; f32x4 wv[4];
        { const bf16* srow = SU + (size_t)((cc - 1) * NH + h) * (HD * HD) + (size_t)dv * HD + 8 * hh;
#pragma unroll
          for (int ks = 0; ks < 8; ++ks) sfr[ks] = *(const bf16x8*)(srow + 16 * ks);
#pragma unroll
          for (int g4 = 0; g4 < 4; ++g4) { gtv[g4] = *(const v2u*)(G + (size_t)(64 * (cc - 1) + trow) * HGW + h * HD + dvb * 32 + 8 * g4 + 4 * hh); wv[g4] = *(const f32x4*)(hg_norm + h * HD + dvb * 32 + 8 * g4 + 4 * hh); } }
        hgrn_cumsum8(g, c);
        *(LAS f32x2*)(SEGT + seg * 128 + 2 * c2) = c[7];
        __syncthreads();
        f32x2 off = {0.f, 0.f}, bmid = {0.f, 0.f};
#pragma unroll
        for (int s = 0; s < 4; ++s) { const f32x2 t = *(const LAS f32x2*)(SEGT + s * 128 + 2 * c2); bmid += t; if (s < seg) off += t; }
#pragma unroll
        for (int s = 4; s < 7; ++s) { const f32x2 t = *(const LAS f32x2*)(SEGT + s * 128 + 2 * c2); if (s < seg) off += t; }
#pragma unroll
        for (int i = 0; i < 8; ++i) {
            const int t = 8 * seg + i; const f32x2 b = off + c[i]; const float q0 = bflo(qw[i]), q1 = bfhi(qw[i]);
            const unsigned qh = pk_bf16(q0 * __expf(b.x), q1 * __expf(b.y));
            const unsigned qt = pk_bf16(q0 * __expf(b.x - bmid.x), q1 * __expf(b.y - bmid.y));
            const unsigned kt = pk_bf16((1.0f - __expf(g[i].x)) * __expf(bmid.x - b.x), (1.0f - __expf(g[i].y)) * __expf(bmid.y - b.y));
            const int o = t * 256 + ((((c2 >> 2) ^ (t & 15))) << 4) + ((c2 & 3) << 2);
            *(LAS unsigned*)(QHh + o) = qh; *(LAS unsigned*)(QT + o) = qt; *(LAS unsigned*)(KT + o) = kt;
        }
        {
          const int sb = seg >> 2, stp = (seg >> 1) & 1, chunk0 = sb * 4 + stp * 2, bo = (seg & 1) << 3, sz = c2 & 7;
          v2u a0, a1, b0, b1;
          a0.x = (vw[0] & 0xffffu) | (vw[1] << 16); a0.y = (vw[2] & 0xffffu) | (vw[3] << 16); b0.x = (vw[4] & 0xffffu) | (vw[5] << 16); b0.y = (vw[6] & 0xffffu) | (vw[7] << 16);
          a1.x = (vw[0] >> 16) | (vw[1] & 0xffff0000u); a1.y = (vw[2] >> 16) | (vw[3] & 0xffff0000u); b1.x = (vw[4] >> 16) | (vw[5] & 0xffff0000u); b1.y = (vw[6] >> 16) | (vw[7] & 0xffff0000u);
          *(LAS v2u*)(VTP + (2 * c2) * 128 + (((chunk0) ^ sz) << 4) + bo) = a0; *(LAS v2u*)(VTP + (2 * c2) * 128 + (((chunk0 + 1) ^ sz) << 4) + bo) = b0;
          *(LAS v2u*)(VTP + (2 * c2 + 1) * 128 + (((chunk0) ^ sz) << 4) + bo) = a1; *(LAS v2u*)(VTP + (2 * c2 + 1) * 128 + (((chunk0 + 1) ^ sz) << 4) + bo) = b1; }
        if (item + F.G < NCH * NH) HC_FETCH(item + F.G);
        __syncthreads();
        f32x16 O;
#pragma unroll
        for (int i = 0; i < 16; ++i) O[i] = 0.f;
        {
#pragma unroll
          for (int ks = 0; ks < 8; ++ks) { const bf16x8 qf = *(const LAS bf16x8*)(QHh + trow * 256 + (((2 * ks + hh) ^ (trow & 15)) << 4)); O = MFMA32(sfr[ks], qf, O); } }
#pragma unroll
        for (int sb = 0; sb < 2; ++sb) {
            if (sb <= tb) {
                f32x16 X;
#pragma unroll
                for (int i = 0; i < 16; ++i) X[i] = 0.f;
                const int srow_ = 32 * sb + l31;
#pragma unroll
                for (int ks = 0; ks < 8; ++ks) { const bf16x8 kf = *(const LAS bf16x8*)(KT + srow_ * 256 + (((2 * ks + hh) ^ (srow_ & 15)) << 4));
                    const bf16x8 qf = *(const LAS bf16x8*)(QT + trow * 256 + (((2 * ks + hh) ^ (trow & 15)) << 4)); X = MFMA32(kf, qf, X); }
                if (sb == tb) {
#pragma unroll
                    for (int i = 0; i < 16; ++i) X[i] = (crow(i, hh) <= l31) ? X[i] : 0.f; }
#pragma unroll
                for (int st = 0; st < 2; ++st) { const bf16x8 pf = pack8(X, st);
                    const bf16x8 vf = *(const LAS bf16x8*)(VTP + dv * 128 + (((sb * 4 + st * 2 + hh) ^ ((dv >> 1) & 7)) << 4)); O = MFMA32(vf, pf, O); }
            }
        }
        float ssq = 0.f;
#pragma unroll
        for (int i = 0; i < 16; ++i) ssq += O[i] * O[i];
        ssq += __shfl_xor(ssq, 32);
        if (hh == 0) SS[(tb * 4 + dvb) * 32 + l31] = ssq;
        __syncthreads();
        const float tot = (SS[(tb * 4 + 0) * 32 + l31] + SS[(tb * 4 + 1) * 32 + l31]) + (SS[(tb * 4 + 2) * 32 + l31] + SS[(tb * 4 + 3) * 32 + l31]);
        const float rstd = 1.0f / sqrtf(tot * (1.0f / HD) + EPS);
        const size_t r = (size_t)(64 * (cc - 1) + trow);
#pragma unroll
        for (int g4 = 0; g4 < 4; ++g4) { const int dv0 = dvb * 32 + 8 * g4 + 4 * hh;
            const f32x4 w = wv[g4]; const v2u gt = gtv[g4];
            v2u o; o.x = pk_bf16(O[4 * g4] * rstd * w.x * bflo(gt.x), O[4 * g4 + 1] * rstd * w.y * bfhi(gt.x)); o.y = pk_bf16(O[4 * g4 + 2] * rstd * w.z * bflo(gt.y), O[4 * g4 + 3] * rstd * w.w * bfhi(gt.y));
            *(v2u*)(MIXED + r * D + h * HD + dv0) = o; }
    }
    __syncthreads();
#undef HC_FETCH
}

__device__ __forceinline__ void kvprep_phase(const Frame& F, const float* kw) {
    const bf16* KVRAW = (const bf16*)(F.ws + AR_KVRAW); const bf16* KR = (const bf16*)(F.ws + AR_KR); const float* CT = (const float*)(F.ws + WS_COS); const float* ST = (const float*)(F.ws + WS_SIN);
    unsigned char* KH = F.ws + AR_KH; unsigned char* VT = F.ws + AR_VT;
    LAS unsigned char* KI = F.lds + RING_OFF;
    LAS bf16* VS = (LAS bf16*)(F.lds + RING_OFF + 24576);
    const int lane = F.lane;
    const float w0 = kw[lane], w1 = kw[64 + lane], w2 = kw[128 + lane];
    for (int item = F.vcu; item < NKT * NH; item += F.G) {
        const int t = item >> 4, h = item & 15;
#pragma unroll 2
        for (int i = 0; i < 8; ++i) {
            const int kk = 8 * F.wave + i, p = 64 * t + kk; const bool valid = p < LTOT; const int r = p < 16 ? SEQ + p : p - 16;
            float x0 = 0.f, x1 = 0.f, x2 = 0.f; unsigned vv = 0u;
            if (valid) { const bf16* src = KVRAW + (size_t)r * 4096 + h * 256; x0 = bf2f(src[lane]); x1 = bf2f(src[64 + lane]); x2 = bf2f(KR[(size_t)r * RD + lane]); vv = *(const unsigned*)(src + 128 + 2 * lane); }
            const float rstd = 1.0f / sqrtf(wave_sum(x0 * x0 + x1 * x1 + x2 * x2) * (1.0f / QKD) + EPS);
            x0 *= rstd * w0; x1 *= rstd * w1; x2 *= rstd * w2;
            const float other = __shfl_xor(x2, 32); const int pc = valid ? p : 0; const float c = CT[pc * 32 + (lane & 31)], s = ST[pc * 32 + (lane & 31)];
            x2 = (lane < 32) ? (x2 * c - other * s) : (x2 * c + other * s);
            const int sz = (kk >> 1) & 7;
#define KOFF(d) (kk * 384 + ((((d) >> 3) & ~7) << 4) + (((((d) >> 3) & 7) ^ sz) << 4) + (((d) & 7) << 1))
            *(LAS bf16*)(KI + KOFF(lane)) = f2bf(x0); *(LAS bf16*)(KI + KOFF(64 + lane)) = f2bf(x1); *(LAS bf16*)(KI + KOFF(128 + lane)) = f2bf(x2);
#undef KOFF
            *(LAS unsigned*)(VS + kk * 136 + 2 * lane) = vv;
        }
        __syncthreads();
        { v4u* dst = (v4u*)(KH + (size_t)(h * NKT + t) * 24576);
#pragma unroll
          for (int j = 0; j < 3; ++j) dst[F.tid + 512 * j] = *(const LAS v4u*)(KI + (F.tid + 512 * j) * 16); }
        { v4u* dst = (v4u*)(VT + (size_t)(h * NKT + t) * 16384);
#pragma unroll
          for (int j = 0; j < 2; ++j) { const int ch = F.tid + 512 * j, dv = ch >> 3, cpos = ch & 7, cl = cpos ^ ((dv >> 1) & 7), kb = cl >> 2, st = (cl >> 1) & 1, hh = cl & 1;
              const int k0 = 32 * kb + 16 * st + 4 * hh; unsigned short e[8];
#pragma unroll
              for (int q = 0; q < 8; ++q) e[q] = VS[(k0 + 8 * (q >> 2) + (q & 3)) * 136 + dv];
              v4u o; o.x = e[0] | ((unsigned)e[1] << 16); o.y = e[2] | ((unsigned)e[3] << 16); o.z = e[4] | ((unsigned)e[5] << 16); o.w = e[6] | ((unsigned)e[7] << 16);
              dst[ch] = o; } }
        __syncthreads();
    }
}

constexpr int ATT_KB = 24576, ATT_VB = 16384;
constexpr int ATT_VBASE = 3 * ATT_KB;
__device__ __forceinline__ void attn_issue_k(const Frame& F, const unsigned char* ktile, LAS unsigned char* buf) {
    unsigned lo = F.lane * 16; asm volatile("" : "+v"(lo));
#pragma unroll
    for (int j = 0; j < 3; ++j) __builtin_amdgcn_global_load_lds((const unsigned*)(ktile + (size_t)(F.wave * 3 + j) * 1024 + lo), (LAS unsigned*)(buf + (F.wave * 3 + j) * 1024), 16, 0, 0);
}
__device__ __forceinline__ void attn_issue_v(const Frame& F, const unsigned char* vtile, LAS unsigned char* buf) {
    unsigned lo = F.lane * 16; asm volatile("" : "+v"(lo));
#pragma unroll
    for (int j = 0; j < 2; ++j) __builtin_amdgcn_global_load_lds((const unsigned*)(vtile + (size_t)(F.wave * 2 + j) * 1024 + lo), (LAS unsigned*)(buf + (F.wave * 2 + j) * 1024), 16, 0, 0);
}
__device__ __forceinline__ float xhalf_max(float v) { const auto r = __builtin_amdgcn_permlane32_swap(__float_as_uint(v), __float_as_uint(v), false, false); return fmaxf(__uint_as_float(r[0]), __uint_as_float(r[1])); }
__device__ __forceinline__ float xhalf_sum(float v) { const auto r = __builtin_amdgcn_permlane32_swap(__float_as_uint(v), __float_as_uint(v), false, false); return __uint_as_float(r[0]) + __uint_as_float(r[1]); }

#define ATT_KLD(ks, r) (*(const LAS bf16x8*)(lds + (kbo + kof[(ks) & 3] + ((ks) >> 2) * 128 + (r) * 12288)))
#define ATT_LDK4(dst, g_) do { dst[0] = ATT_KLD(2 * (g_), 0); dst[1] = ATT_KLD(2 * (g_), 1); dst[2] = ATT_KLD(2 * (g_) + 1, 0); dst[3] = ATT_KLD(2 * (g_) + 1, 1); } while (0)
#define ATT_MMK4(src, g_) do { S0 = MFMA32(src[0], qf(2 * (g_)), S0); S1 = MFMA32(src[1], qf(2 * (g_)), S1); S0 = MFMA32(src[2], qf(2 * (g_) + 1), S0); S1 = MFMA32(src[3], qf(2 * (g_) + 1), S1); } while (0)
#define ATT_QK(t_, bcur_) do { \
    _Pragma("unroll") for (int i = 0; i < 16; ++i) { S0[i] = negM; S1[i] = negM; }     \
    if (64 * (t_) <= 16 + q0 + 31) { \
        const int kbo = (bcur_) * ATT_KB; \
        bf16x8 ka[4], kb[4], kc[4];                  \
        ATT_LDK4(ka, 0); __builtin_amdgcn_sched_barrier(0); ATT_LDK4(kb, 1); __builtin_amdgcn_sched_barrier(0); \
        ATT_LDK4(kc, 2); __builtin_amdgcn_sched_barrier(0); ATT_MMK4(ka, 0); __builtin_amdgcn_sched_barrier(0); \
        ATT_LDK4(ka, 3); __builtin_amdgcn_sched_barrier(0); ATT_MMK4(kb, 1); __builtin_amdgcn_sched_barrier(0); \
        ATT_LDK4(kb, 4); __builtin_amdgcn_sched_barrier(0); ATT_MMK4(kc, 2); __builtin_amdgcn_sched_barrier(0); \
        ATT_LDK4(kc, 5); __builtin_amdgcn_sched_barrier(0); ATT_MMK4(ka, 3); __builtin_amdgcn_sched_barrier(0); \
        ATT_MMK4(kb, 4); __builtin_amdgcn_sched_barrier(0); ATT_MMK4(kc, 5); __builtin_amdgcn_sched_barrier(0); } } while (0)

#define ATT_SMPV(t_, bcur_) do { if (64 * (t_) <= 16 + q0 + 31) { \
    if (64 * (t_) + 63 > 16 + q0) { const int dh = qpos - 64 * (t_) - 4 * hh;     \
        _Pragma("unroll") for (int i = 0; i < 16; ++i) { S0[i] = ((i & 3) + 8 * (i >> 2) <= dh) ? S0[i] : -__builtin_inff(); S1[i] = ((i & 3) + 8 * (i >> 2) + 32 <= dh) ? S1[i] : -__builtin_inff(); } } \
    float ps = 0.f; \
    _Pragma("unroll") for (int i = 0; i < 16; ++i) { S0[i] = __builtin_amdgcn_exp2f(S0[i]); S1[i] = __builtin_amdgcn_exp2f(S1[i]); ps += S0[i] + S1[i]; } \
    l_run += ps; \
    const bf16x8 p00 = pack8(S0, 0), p01 = pack8(S0, 1), p10 = pack8(S1, 0), p11 = pack8(S1, 1); \
    const int vbo = ATT_VBASE + (bcur_) * ATT_VB; \
    bf16x8 va[4], vb[4], vc[4]; \
    va[0] = ATT_VF(0, 0); va[1] = ATT_VF(0, 2); va[2] = ATT_VF(0, 4); va[3] = ATT_VF(0, 6); \
    __builtin_amdgcn_sched_barrier(0); \
    vb[0] = ATT_VF(1, 0); vb[1] = ATT_VF(1, 2); vb[2] = ATT_VF(1, 4); vb[3] = ATT_VF(1, 6); \
    __builtin_amdgcn_sched_barrier(0); \
    vc[0] = ATT_VF(2, 0); vc[1] = ATT_VF(2, 2); vc[2] = ATT_VF(2, 4); vc[3] = ATT_VF(2, 6); \
    __builtin_amdgcn_sched_barrier(0); \
    O0 = MFMA32(va[0], p00, O0); O0 = MFMA32(va[1], p01, O0); O0 = MFMA32(va[2], p10, O0); O0 = MFMA32(va[3], p11, O0); \
    __builtin_amdgcn_sched_barrier(0); \
    va[0] = ATT_VF(3, 0); va[1] = ATT_VF(3, 2); va[2] = ATT_VF(3, 4); va[3] = ATT_VF(3, 6); \
    __builtin_amdgcn_sched_barrier(0); \
    O1 = MFMA32(vb[0], p00, O1); O1 = MFMA32(vb[1], p01, O1); O1 = MFMA32(vb[2], p10, O1); O1 = MFMA32(vb[3], p11, O1); \
    __builtin_amdgcn_sched_barrier(0); \
    O2 = MFMA32(vc[0], p00, O2); O2 = MFMA32(vc[1], p01, O2); O2 = MFMA32(vc[2], p10, O2); O2 = MFMA32(vc[3], p11, O2); \
    __builtin_amdgcn_sched_barrier(0); \
    O3 = MFMA32(va[0], p00, O3); O3 = MFMA32(va[1], p01, O3); O3 = MFMA32(va[2], p10, O3); O3 = MFMA32(va[3], p11, O3); \
    __builtin_amdgcn_sched_barrier(0); } } while (0)
#define ATT_VF(dvb, c) (*(const LAS bf16x8*)(lds + (vbo + vof[(c) >> 1] + (dvb) * 4096)))
#define ATT_WAIT(n) asm volatile("s_waitcnt vmcnt(" #n ")" ::: "memory")
#define ATT_BAR() do { asm volatile("s_waitcnt lgkmcnt(0)" ::: "memory"); __builtin_amdgcn_s_barrier(); asm volatile("" ::: "memory"); } while (0)

__device__ __forceinline__ void attn_unit(const Frame& F, int h, int qb, const float* qw, float negM, bool desc) {
    unsigned char* wsl = F.ws; asm volatile("" : "+s"(wsl));
    const bf16* QRAW = (const bf16*)(wsl + AR_QRAW); const float* CT = (const float*)(wsl + WS_COS); const float* ST = (const float*)(wsl + WS_SIN);
    const unsigned char* KH = wsl + AR_KH + (size_t)h * NKT * ATT_KB; const unsigned char* VT = wsl + AR_VT + (size_t)h * NKT * ATT_VB;
    LAS unsigned char* lds = F.lds + RING_OFF;
    int lane = F.lane; asm volatile("" : "+v"(lane));
    const int hh = lane >> 5, l31 = lane & 31, sz = (l31 >> 1) & 7;
    const bool grpA = F.wave < 4;
    const int q0 = 256 * qb + 32 * F.wave;
    const int qpos = 16 + q0 + l31;
    const int nt = (256 * qb + 271) / 64 + 1;
    v4u qv[12];
#define qf(ks) (__builtin_bit_cast(bf16x8, qv[ks]))
    { const bf16* qrow = (QRAW + (size_t)q0 * 3072 + h * QKD) + (unsigned)(l31 * 3072 + 8 * hh);
#pragma unroll
      for (int ks = 0; ks < 12; ++ks) qv[ks] = *(const v4u*)(qrow + 16 * ks);
      { const int ta = desc ? nt - 1 : 0, tb2 = desc ? nt - 2 : 1;
        attn_issue_k(F, KH + (size_t)ta * ATT_KB, lds); attn_issue_v(F, VT + (size_t)ta * ATT_VB, lds + ATT_VBASE);
        attn_issue_k(F, KH + (size_t)tb2 * ATT_KB, lds + ATT_KB); attn_issue_v(F, VT + (size_t)tb2 * ATT_VB, lds + ATT_VBASE + ATT_VB); }
      float ss = 0.f;
#pragma unroll
      for (int ks = 0; ks < 12; ++ks) { const v4u w = qv[ks]; const float a0 = bflo(w.x), a1 = bfhi(w.x), a2 = bflo(w.y), a3 = bfhi(w.y), a4 = bflo(w.z), a5 = bfhi(w.z), a6 = bflo(w.w), a7 = bfhi(w.w);
          ss += (a0 * a0 + a1 * a1) + (a2 * a2 + a3 * a3) + (a4 * a4 + a5 * a5) + (a6 * a6 + a7 * a7); }
      ss = xhalf_sum(ss);
#pragma unroll
      for (int ks = 0; ks < 12; ++ks) asm volatile("" : "+v"(qv[ks]));
      const float rs = QSCALE / sqrtf(ss * (1.0f / QKD) + EPS);
#pragma unroll
      for (int ks = 0; ks < 8; ++ks) { const v4u w = qv[ks]; const f32x4 g0 = *(const f32x4*)(qw + 16 * ks + 8 * hh), g1 = *(const f32x4*)(qw + 16 * ks + 8 * hh + 4);
          v4u o; o.x = pk_bf16(bflo(w.x) * rs * g0[0], bfhi(w.x) * rs * g0[1]); o.y = pk_bf16(bflo(w.y) * rs * g0[2], bfhi(w.y) * rs * g0[3]);
          o.z = pk_bf16(bflo(w.z) * rs * g1[0], bfhi(w.z) * rs * g1[1]); o.w = pk_bf16(bflo(w.w) * rs * g1[2], bfhi(w.w) * rs * g1[3]); qv[ks] = o;
          if (ks & 1) asm volatile("" ::: "memory"); }
#pragma unroll
      for (int a = 0; a < 2; ++a) {
          const v4u w1 = qv[8 + a], w2 = qv[10 + a]; const int i0 = 16 * a + 8 * hh;
          const f32x4 ga0 = *(const f32x4*)(qw + 128 + i0), ga1 = *(const f32x4*)(qw + 128 + i0 + 4), gb0 = *(const f32x4*)(qw + 160 + i0), gb1 = *(const f32x4*)(qw + 160 + i0 + 4);
          const float* ctp = (CT + (size_t)(16 + q0) * 32 + 16 * a) + (unsigned)(l31 * 32 + 8 * hh); const float* stp = (ST + (size_t)(16 + q0) * 32 + 16 * a) + (unsigned)(l31 * 32 + 8 * hh);
          const f32x4 c0 = *(const f32x4*)ctp, c1 = *(const f32x4*)(ctp + 4), s0 = *(const f32x4*)stp, s1 = *(const f32x4*)(stp + 4);
          float x1[8] = {bflo(w1.x) * ga0[0], bfhi(w1.x) * ga0[1], bflo(w1.y) * ga0[2], bfhi(w1.y) * ga0[3], bflo(w1.z) * ga1[0], bfhi(w1.z) * ga1[1], bflo(w1.w) * ga1[2], bfhi(w1.w) * ga1[3]};
          float x2[8] = {bflo(w2.x) * gb0[0], bfhi(w2.x) * gb0[1], bflo(w2.y) * gb0[2], bfhi(w2.y) * gb0[3], bflo(w2.z) * gb1[0], bfhi(w2.z) * gb1[1], bflo(w2.w) * gb1[2], bfhi(w2.w) * gb1[3]};
          const float cc[8] = {c0[0], c0[1], c0[2], c0[3], c1[0], c1[1], c1[2], c1[3]}, sn[8] = {s0[0], s0[1], s0[2], s0[3], s1[0], s1[1], s1[2], s1[3]};
          float y1[8], y2[8];
#pragma unroll
          for (int j = 0; j < 8; ++j) { y1[j] = (x1[j] * cc[j] - x2[j] * sn[j]) * rs; y2[j] = (x2[j] * cc[j] + x1[j] * sn[j]) * rs; }
          v4u o1, o2; o1.x = pk_bf16(y1[0], y1[1]); o1.y = pk_bf16(y1[2], y1[3]); o1.z = pk_bf16(y1[4], y1[5]); o1.w = pk_bf16(y1[6], y1[7]);
          o2.x = pk_bf16(y2[0], y2[1]); o2.y = pk_bf16(y2[2], y2[3]); o2.z = pk_bf16(y2[4], y2[5]); o2.w = pk_bf16(y2[6], y2[7]);
          qv[8 + a] = o1; qv[10 + a] = o2; asm volatile("" ::: "memory"); }
    }
    int kof[4], vof[4];
#pragma unroll
    for (int c2 = 0; c2 < 4; ++c2) { const int slot = (((2 * c2 + hh) ^ sz) & 7) << 4; kof[c2] = l31 * 384 + slot; vof[c2] = l31 * 128 + slot; }
    f32x16 O0, O1, O2, O3, S0, S1;
#pragma unroll
    for (int i = 0; i < 16; ++i) { O0[i] = 0.f; O1[i] = 0.f; O2[i] = 0.f; O3[i] = 0.f; S0[i] = 0.f; S1[i] = 0.f; }
    float l_run = 0.f;
    ATT_WAIT(7); ATT_BAR();
#define ATT_TILE(i_) (desc ? nt - 1 - (i_) : (i_))
#define ATT_ISSUE_K() attn_issue_k(F, KH + (size_t)ATT_TILE((t + 2 < nt) ? t + 2 : nt - 1) * ATT_KB, lds + b2 * ATT_KB)
#define ATT_ISSUE_V() attn_issue_v(F, VT + (size_t)ATT_TILE((t + 2 < nt) ? t + 2 : nt - 1) * ATT_VB, lds + ATT_VBASE + b2 * ATT_VB)
#define ATT_ROT() do { bp = b0; b0 = (b0 == 2) ? 0 : b0 + 1; b2 = (b2 == 2) ? 0 : b2 + 1; } while (0)
    int b0 = 0, b2 = 2, bp = 2;
    if (grpA) {
#pragma unroll 1
        for (int t = 0; t < nt; ++t) {
            const int tl = ATT_TILE(t);
            ATT_ISSUE_K(); ATT_QK(tl, b0); ATT_WAIT(8); ATT_BAR();
            ATT_ISSUE_V(); ATT_SMPV(tl, b0); ATT_WAIT(7); ATT_BAR();
            ATT_ROT();
        }
    } else {
#pragma unroll 1
        for (int t = 0; t < nt; ++t) {
            const int tl = ATT_TILE(t), tlp = ATT_TILE(t - 1);
            ATT_ISSUE_K(); if (t > 0) { ATT_SMPV(tlp, bp); } ATT_WAIT(8); ATT_BAR();
            ATT_ISSUE_V(); ATT_QK(tl, b0); ATT_WAIT(7); ATT_BAR();
            ATT_ROT();
        }
        { const int tll = ATT_TILE(nt - 1); ATT_SMPV(tll, bp); }
    }
#undef ATT_ROT
#undef ATT_TILE
#undef ATT_ISSUE_K
#undef ATT_ISSUE_V
    ATT_WAIT(0); ATT_BAR();
    const float inv = 1.0f / xhalf_sum(l_run);
    bf16* orow = ((bf16*)(wsl + AR_MIXED) + (size_t)q0 * D + HGW + h * HD) + (unsigned)(l31 * D + 4 * hh);
#pragma unroll
    for (int g4 = 0; g4 < 4; ++g4) {
        v2u o;
        o.x = pk_bf16(O0[4 * g4] * inv, O0[4 * g4 + 1] * inv); o.y = pk_bf16(O0[4 * g4 + 2] * inv, O0[4 * g4 + 3] * inv); *(v2u*)(orow + 0 + 8 * g4) = o;
        o.x = pk_bf16(O1[4 * g4] * inv, O1[4 * g4 + 1] * inv); o.y = pk_bf16(O1[4 * g4 + 2] * inv, O1[4 * g4 + 3] * inv); *(v2u*)(orow + 32 + 8 * g4) = o;
        o.x = pk_bf16(O2[4 * g4] * inv, O2[4 * g4 + 1] * inv); o.y = pk_bf16(O2[4 * g4 + 2] * inv, O2[4 * g4 + 3] * inv); *(v2u*)(orow + 64 + 8 * g4) = o;
        o.x = pk_bf16(O3[4 * g4] * inv, O3[4 * g4 + 1] * inv); o.y = pk_bf16(O3[4 * g4 + 2] * inv, O3[4 * g4 + 3] * inv); *(v2u*)(orow + 96 + 8 * g4) = o;
    }
}
#undef ATT_QK
#undef qf
#undef ATT_KLD
#undef ATT_LDK4
#undef ATT_MMK4
#undef ATT_SMPV
#undef ATT_VF
#undef ATT_WAIT
#undef ATT_BAR
__device__ __forceinline__ void attn_phase(const Frame& F, const float* qw, const float* kw) {
    float gq = fmaxf(fmaxf(fabsf(qw[F.lane]), fabsf(qw[64 + F.lane])), fabsf(qw[128 + F.lane])), gk = fmaxf(fmaxf(fabsf(kw[F.lane]), fabsf(kw[64 + F.lane])), fabsf(kw[128 + F.lane]));
#pragma unroll
    for (int o = 1; o < 64; o <<= 1) { gq = fmaxf(gq, __shfl_xor(gq, o)); gk = fmaxf(gk, __shfl_xor(gk, o)); }
    const float negM = -(1.01f * 13.856406460551018f * 1.4426950408889634f) * gq * gk;
    if (F.wave >= 4) __builtin_amdgcn_s_setprio(1);
    for (int item = F.vcu; item < NH * 32; item += F.G) {
        const int h = item >> 5, pr = item & 31;
#pragma unroll 1
        for (int u = 0; u < 2; ++u) attn_unit(F, h, u ? pr : 63 - pr, qw, negM, false);
    }
    __builtin_amdgcn_s_setprio(0);
}

constexpr int N_PHASES = 14;
#ifndef WGM_GU
#define WGM_GU 8
#endif
#ifndef WGM_IN
#define WGM_IN 8
#endif
#ifndef WGM_DOWN
#define WGM_DOWN 4
#endif
#ifndef PROBE_PHASE
#define PROBE_PHASE -1
#endif
#define REP(k) for (int rep_ = 0; rep_ < ((PROBE_PHASE == (k)) ? 2 : 1); ++rep_)
#define RSCALE(k, s) ((PROBE_PHASE == (k) && rep_ == 0) ? 0.0f : (s))
__global__ void __launch_bounds__(NWAVES * 64, 2) fwd_kernel(Args args) {
    extern __shared__ __attribute__((aligned(16))) unsigned char lds_raw[];
    Frame F;
    F.lds = (LAS unsigned char*)lds_raw;
    F.tid = threadIdx.x; F.lane = F.tid & 63; F.wave = __builtin_amdgcn_readfirstlane(F.tid >> 6);
    F.G = gridDim.x; { const int bx = blockIdx.x; F.vcu = (F.G % 8 == 0) ? (bx % 8) * (F.G / 8) + bx / 8 : bx; }
    F.ws = args.ws; F.out = args.out;
    unsigned char* ws = args.ws;
    for (int u = F.tid; u < (LDS_BYTES - LDSCTL_OFF) / 4; u += NWAVES * 64) ((LAS unsigned*)(F.lds + LDSCTL_OFF))[u] = 0u;
    __syncthreads();
    XcdBarrier bar; bar.bar = (unsigned*)(ws + WS_CTL) + CW_BAR; bar.x = 0; bar.st = nullptr;
    const int lo = args.ph_lo, hi = args.ph_hi;
    if (hi - lo > 1) bar = xcd_barrier_post((unsigned*)(ws + WS_CTL) + CW_BAR, (volatile LAS unsigned*)(F.lds + MISC_OFF) + 8);
#define IN(k) (lo <= (k) && (k) < hi)
#define SEAM(k) do { if (IN(k) && IN((k) + 1)) xcd_barrier(bar); { int t_ = threadIdx.x; asm volatile("" : "+v"(t_)); F.tid = t_; F.lane = t_ & 63; } } while (0)
    float* HM = (float*)(ws + WS_HM);
    bf16* XN = (bf16*)(ws + AR_XN); bf16* ACT = (bf16*)(ws + AR_ACT);

    float* STAT1 = (float*)(ws + WS_CTL + CTL_STAT1); float* STAT2 = (float*)(ws + WS_CTL + CTL_STAT2);

    if (IN(0)) REP(0) { p0_prologue(F, args); __syncthreads(); } SEAM(0);

    if (IN(1)) REP(1) {
        pg8::Gemm g{XN, (const bf16*)(ws + WS_W1GU), MP, 2 * DFF, D}; pg8::StaticOrder S; S.init(MP, 2 * DFF, F.G, (int)blockIdx.x, WGM_GU);
        pg8::EpiSwiglu<false> E{ACT, DFF, nullptr};
        pg8::gemm_phase<pg8::EpiSwiglu<false>, pg8::StaticOrder, true, true>(F.lds + RING_OFF, g, S, E);
    } SEAM(1);

    if (IN(2)) {
        pg8::Gemm g{ACT, (const bf16*)(ws + WS_W1D), SEQ, D, DFF}; pg8::StaticOrder S; S.init(SEQ, D, F.G, (int)blockIdx.x, WGM_DOWN);
        typedef pg8::EpiResid<true, AR_XN, WS_CTL + CTL_STAT1, WS_G1> Epi; Epi E{args.in[0], F.out, D, 0.5f, ws};
        pg8::gemm_phase<Epi, pg8::StaticOrder, true, true>(F.lds + RING_OFF, g, S, E);
        meta_down_phase(F, ACT, (const bf16*)(ws + WS_W1D), HM, 0.5f, XN, STAT1, (const float*)(ws + WS_G1));
    } SEAM(2);

    if (IN(3)) REP(3) {
        zero_null_rows(F);
        pg8::Gemm g{XN, (const bf16*)(ws + WS_WIN), MP, INCP, D}; pg8::StaticOrder S; S.init(MP, INCP, F.G, (int)blockIdx.x, WGM_IN);
        pg8::EpiWin E{(bf16*)(ws + AR_HQ), (bf16*)(ws + AR_HV), (bf16*)(ws + AR_G), (bf16*)(ws + AR_CQ), (bf16*)(ws + AR_CKV), (bf16*)(ws + AR_KR), (float*)(ws + AR_LOGF), (const float*)(ws + WS_LB), STAT1};
        pg8::gemm_phase<pg8::EpiWin, pg8::StaticOrder, true, true>(F.lds + RING_OFF, g, S, E);
    } SEAM(3);

    if (IN(4)) REP(4) {
        lat_norm<QL>(F, (const bf16*)(ws + AR_CQ), args.in[10], (bf16*)(ws + AR_CQN), LTOT, MP);
        lat_norm<KVL>(F, (const bf16*)(ws + AR_CKV), args.in[12], (bf16*)(ws + AR_CKVN), LTOT, MP);
        hgrn_pass_a(F);
    } SEAM(4);

    if (IN(5)) { hgrn_pass_b(F); } SEAM(5);
    if (IN(6)) REP(6) { hgrn_pass_c(F, args.in[9]); } SEAM(6);

    if (IN(7)) REP(7) {
        { pg8::Gemm g{(const bf16*)(ws + AR_CQN), (const bf16*)(ws + WS_WUQ), SEQ, 3072, QL}; pg8::StaticOrder S; S.init(SEQ, 3072, F.G, (int)blockIdx.x);
          pg8::EpiPlain E{(bf16*)(ws + AR_QRAW), 3072};
          pg8::gemm_phase<pg8::EpiPlain, pg8::StaticOrder, true, true>(F.lds + RING_OFF, g, S, E); }
        { pg8::Gemm g{(const bf16*)(ws + AR_CKVN), (const bf16*)(ws + WS_WUKV), MP, 4096, KVL}; pg8::StaticOrder S; S.init(MP, 4096, F.G, (int)blockIdx.x);
          pg8::EpiPlain E{(bf16*)(ws + AR_KVRAW), 4096};
          pg8::gemm_phase<pg8::EpiPlain, pg8::StaticOrder, true, true>(F.lds + RING_OFF, g, S, E); }
    } SEAM(7);

    if (IN(8)) REP(8) { kvprep_phase(F, args.in[15]); } SEAM(8);

    if (IN(9)) { attn_phase(F, args.in[14], args.in[15]); if (PROBE_PHASE == 9) attn_phase(F, args.in[14], args.in[15]); } SEAM(9);

    if (IN(10)) {
        pg8::Gemm g{(const bf16*)(ws + AR_MIXED), (const bf16*)(ws + WS_WOUT), SEQ, D, D}; pg8::StaticOrder S; S.init(SEQ, D, F.G, (int)blockIdx.x, WGM_DOWN);
        typedef pg8::EpiResid<true, AR_XN2, WS_CTL + CTL_STAT2, WS_G2> Epi; Epi E{F.out, F.out, D, 1.0f, ws};
        pg8::gemm_phase<Epi, pg8::StaticOrder, true, true>(F.lds + RING_OFF, g, S, E);
    } SEAM(10);

    if (IN(11)) REP(11) {
        pg8::Gemm g{(const bf16*)(ws + AR_XN2), (const bf16*)(ws + WS_W2GU), SEQ, 2 * DFF, D}; pg8::StaticOrder S; S.init(SEQ, 2 * DFF, F.G, (int)blockIdx.x, WGM_GU);
        pg8::EpiSwiglu<true> E{ACT, DFF, STAT2};
        pg8::gemm_phase<pg8::EpiSwiglu<true>, pg8::StaticOrder, true, true>(F.lds + RING_OFF, g, S, E);
    } SEAM(11);

    if (IN(12)) {
        pg8::Gemm g{ACT, (const bf16*)(ws + WS_W2D), SEQ, D, DFF}; pg8::StaticOrder S; S.init(SEQ, D, F.G, (int)blockIdx.x, WGM_DOWN);
        typedef pg8::EpiResid<false, 0, 0, 0> Epi; Epi E{F.out, F.out, D, 0.5f, ws};
        pg8::gemm_phase<Epi, pg8::StaticOrder, true, true>(F.lds + RING_OFF, g, S, E);
    } SEAM(12);

    if (IN(13)) { final_norm(F, args.in[21]); }
#undef IN
#undef SEAM
}

extern "C" void kernel_launch(void* const* d_in, const int* in_sizes, int n_in, void* d_out, int out_size, void* d_ws, size_t ws_size, hipStream_t stream) {
    static int grid = 0;
    if (grid == 0) {
        if (n_in != 22 || out_size != SEQ * D || ws_size < WS_END) { fprintf(stderr, "kernel_launch: unexpected shapes (n_in %d, out %d, ws %zu < %zu)\n", n_in, out_size, ws_size, (size_t)WS_END); grid = -1; return; }
        int dev = 0, cus = 0, per_cu = 0;
        if (hipGetDevice(&dev) != hipSuccess || hipDeviceGetAttribute(&cus, hipDeviceAttributeMultiprocessorCount, dev) != hipSuccess) { grid = -1; return; }
        if (hipFuncSetAttribute((const void*)fwd_kernel, hipFuncAttributeMaxDynamicSharedMemorySize, LDS_BYTES) != hipSuccess) { fprintf(stderr, "kernel_launch: hipFuncSetAttribute failed\n"); grid = -1; return; }
        if (hipOccupancyMaxActiveBlocksPerMultiprocessor(&per_cu, (const void*)fwd_kernel, NWAVES * 64, LDS_BYTES) != hipSuccess || per_cu < 1) fprintf(stderr, "kernel_launch: occupancy query says %d\n", per_cu);
        (void)hipGetLastError();
        grid = cus;
    }
    if (grid < 0) return;
    if (hipMemsetAsync((char*)d_ws + WS_CTL, 0, CTL_ZERO_BYTES, stream) != hipSuccess) return;
    Args a{};
    for (int i = 0; i < 22; ++i) a.in[i] = (const float*)d_in[i];
    a.out = (float*)d_out; a.ws = (unsigned char*)d_ws;
#if MK_SINGLE
    a.ph_lo = 0; a.ph_hi = N_PHASES;
    hipLaunchKernelGGL(fwd_kernel, dim3(grid), dim3(NWAVES * 64), LDS_BYTES, stream, a);
#else
    for (int p = 0; p < N_PHASES; ++p) { a.ph_lo = p; a.ph_hi = p + 1; hipLaunchKernelGGL(fwd_kernel, dim3(grid), dim3(NWAVES * 64), LDS_BYTES, stream, a); }
#endif
}
```
